# Optimizing an MI355X kernel written in HIP

```python
import jax, jax.numpy as jnp
from jax import lax
import numpy as np

D_MODEL = 1024
BATCH = 8
SEQ = 4096
DEPTH = 1

D_MIX = 2 * D_MODEL
D_SSD = D_MIX // 2
D_ATT = D_MIX - D_SSD
SSD_HEADDIM = 64
SSD_HEADS = D_SSD // SSD_HEADDIM
SSD_GROUPS = 2
SSD_STATE = 128
CONV_K = 4
CHUNK = 128
ATT_HEAD_DIM = 64
ATT_Q_HEADS = D_ATT // ATT_HEAD_DIM
ATT_KV_HEADS = 4
WINDOW = 128
ROPE_THETA = 500000.0
ROPE_DIM = ATT_HEAD_DIM // 4
ALPHA = (2.0 * DEPTH) ** 0.25
BETA = (8.0 * DEPTH) ** -0.25
LN_EPS = 1e-5
RMS_EPS = 1e-5

D_BC = SSD_GROUPS * SSD_STATE
D_XBC = D_SSD + 2 * D_BC
D_KV = ATT_KV_HEADS * ATT_HEAD_DIM
OFF_Z = 0
OFF_XBC = OFF_Z + D_SSD
OFF_DT = OFF_XBC + D_XBC
OFF_Q = OFF_DT + SSD_HEADS
OFF_K = OFF_Q + D_ATT
OFF_V = OFF_K + D_KV
OFF_G = OFF_V + D_KV
D_IN_PROJ = OFF_G + D_ATT
SPLIT_IDX = (OFF_XBC, OFF_DT, OFF_Q, OFF_K, OFF_V, OFF_G)

kernel_name = "hybrid_ssd_swa_sink_deepnorm"


def layer_norm(x, g, b):
    xf = x.astype(jnp.float32)
    mu = jnp.mean(xf, axis=-1, keepdims=True)
    var = jnp.mean(jnp.square(xf - mu), axis=-1, keepdims=True)
    y = (xf - mu) * lax.rsqrt(var + LN_EPS) * g.astype(jnp.float32) + b.astype(jnp.float32)
    return y.astype(x.dtype)


def rope_tables(positions):
    inv = ROPE_THETA ** (-jnp.arange(0, ROPE_DIM, 2, dtype=jnp.float32) / ROPE_DIM)
    ang = positions.astype(jnp.float32)[..., None] * inv
    return jnp.cos(ang), jnp.sin(ang)


def apply_partial_rope(t, cos, sin):
    rot = t[..., :ROPE_DIM].astype(jnp.float32)
    rest = t[..., ROPE_DIM:]
    r1, r2 = rot[..., :ROPE_DIM // 2], rot[..., ROPE_DIM // 2:]
    c, s = cos[:, :, None, :], sin[:, :, None, :]
    rot = jnp.concatenate([r1 * c - r2 * s, r2 * c + r1 * s], axis=-1)
    return jnp.concatenate([rot.astype(t.dtype), rest], axis=-1)


def causal_depthwise_conv(u, w, b):
    c = u.shape[-1]
    out = lax.conv_general_dilated(
        u, w[:, None, :].astype(u.dtype), window_strides=(1,),
        padding=[(CONV_K - 1, 0)], dimension_numbers=("NWC", "WIO", "NWC"),
        feature_group_count=c)
    return out + b.astype(u.dtype)


def gated_rmsnorm(y, z, w):
    yf = (y.astype(jnp.float32) * jax.nn.silu(z.astype(jnp.float32)))
    yg = yf.reshape(*yf.shape[:-1], SSD_GROUPS, D_SSD // SSD_GROUPS)
    yg = yg * lax.rsqrt(jnp.mean(jnp.square(yg), axis=-1, keepdims=True) + RMS_EPS)
    return yg.reshape(yf.shape) * w.astype(jnp.float32)


def ssd_chunked(X, dA, Bc, Cc):
    a = jnp.moveaxis(dA, 2, -1).astype(jnp.float32)
    a_cs = jnp.cumsum(a, axis=-1)
    T = a.shape[-1]
    causal = jnp.tril(jnp.ones((T, T), dtype=bool))
    seg = a_cs[..., :, None] - a_cs[..., None, :]
    Lmat = jnp.where(causal, jnp.exp(jnp.where(causal, seg, 0.0)), 0.0)
    cb = jnp.einsum("bclgn,bcsgn->bcgls", Cc, Bc).astype(jnp.float32)
    M = cb[:, :, :, None] * Lmat
    y_diag = jnp.einsum("bcgrls,bcsgrp->bclgrp", M, X)
    decay_states = jnp.moveaxis(jnp.exp(a_cs[..., -1:] - a_cs), -1, 2)
    states = jnp.einsum("bclgn,bclgrp->bcgrpn", Bc, X * decay_states[..., None]).astype(jnp.float32)
    chunk_decay = jnp.exp(a_cs[..., -1])

    def step(h, inp):
        s_c, d_c = inp
        return h * d_c[..., None, None] + s_c, h

    h0 = jnp.zeros(states.shape[:1] + states.shape[2:], jnp.float32)
    _, prev = lax.scan(step, h0, (jnp.moveaxis(states, 1, 0), jnp.moveaxis(chunk_decay, 1, 0)))
    prev = jnp.moveaxis(prev, 0, 1)
    decay_out = jnp.moveaxis(jnp.exp(a_cs), -1, 2)
    y_off = jnp.einsum("bclgn,bcgrpn->bclgrp", Cc, prev) * decay_out[..., None]
    return y_diag + y_off


def ssd_branch(z, xbc, dt, conv_w, conv_b, dt_bias, a_log, d_skip, norm_w):
    b, L, _ = xbc.shape
    R = SSD_HEADS // SSD_GROUPS
    nc = L // CHUNK
    xbc = jax.nn.silu(causal_depthwise_conv(xbc, conv_w, conv_b))
    xs, Bm, Cm = jnp.split(xbc, [D_SSD, D_SSD + D_BC], axis=-1)
    dt = jax.nn.softplus(dt.astype(jnp.float32) + dt_bias.astype(jnp.float32))
    A = -jnp.exp(a_log.astype(jnp.float32))
    xh = xs.reshape(b, L, SSD_GROUPS, R, SSD_HEADDIM)
    dth = dt.reshape(b, L, SSD_GROUPS, R)
    X = (xh.astype(jnp.float32) * dth[..., None]).reshape(b, nc, CHUNK, SSD_GROUPS, R, SSD_HEADDIM)
    dA = (dth * A.reshape(SSD_GROUPS, R)).reshape(b, nc, CHUNK, SSD_GROUPS, R)
    Bc = Bm.reshape(b, nc, CHUNK, SSD_GROUPS, SSD_STATE)
    Cc = Cm.reshape(b, nc, CHUNK, SSD_GROUPS, SSD_STATE)
    y = ssd_chunked(X, dA, Bc, Cc).reshape(b, L, SSD_GROUPS, R, SSD_HEADDIM)
    y = y + d_skip.astype(jnp.float32).reshape(SSD_GROUPS, R, 1) * xh.astype(jnp.float32)
    y = gated_rmsnorm(y.reshape(b, L, D_SSD), z, norm_w)
    return y.astype(z.dtype)


def swa_branch(q, k, v, g, cos, sin, sinks):
    b, L, _ = q.shape
    nb = L // WINDOW
    R = ATT_Q_HEADS // ATT_KV_HEADS
    q = apply_partial_rope(q.reshape(b, L, ATT_Q_HEADS, ATT_HEAD_DIM), cos, sin)
    k = apply_partial_rope(k.reshape(b, L, ATT_KV_HEADS, ATT_HEAD_DIM), cos, sin)
    v = v.reshape(b, L, ATT_KV_HEADS, ATT_HEAD_DIM)
    qb = q.reshape(b, nb, WINDOW, ATT_KV_HEADS, R, ATT_HEAD_DIM)
    kb = k.reshape(b, nb, WINDOW, ATT_KV_HEADS, ATT_HEAD_DIM)
    vb = v.reshape(b, nb, WINDOW, ATT_KV_HEADS, ATT_HEAD_DIM)
    pad = ((0, 0), (1, 0), (0, 0), (0, 0), (0, 0))
    kk = jnp.concatenate([jnp.pad(kb[:, :-1], pad), kb], axis=2)
    vv = jnp.concatenate([jnp.pad(vb[:, :-1], pad), vb], axis=2)
    scale = ATT_HEAD_DIM ** -0.5
    s = jnp.einsum("bnqkrd,bnskd->bnkrqs", qb, kk).astype(jnp.float32) * scale
    qi = jnp.arange(WINDOW)[:, None]
    si = jnp.arange(2 * WINDOW)[None, :]
    band = (si > qi) & (si <= qi + WINDOW)
    valid = band[None] & ((jnp.arange(nb)[:, None, None] > 0) | (si[None] >= WINDOW))
    s = jnp.where(valid[None, :, None, None], s, -jnp.inf)
    sink = sinks.astype(jnp.float32).reshape(ATT_KV_HEADS, R)[None, None, :, :, None, None]
    m = jnp.maximum(jnp.max(s, axis=-1, keepdims=True), sink)
    p = jnp.exp(s - m)
    denom = jnp.sum(p, axis=-1, keepdims=True) + jnp.exp(sink - m)
    o = jnp.einsum("bnkrqs,bnskd->bnqkrd", (p / denom).astype(vv.dtype), vv)
    o = o.reshape(b, L, D_ATT)
    return (o * jax.nn.silu(g.astype(jnp.float32))).astype(q.dtype)


def hybrid_mixer(x, cos, sin, w_in, conv_w, conv_b, dt_bias, a_log, d_skip, ssd_norm_w, attn_sinks, w_out):
    proj = jnp.einsum("bld,de->ble", x, w_in)
    z, xbc, dt, q, k, v, g = jnp.split(proj, SPLIT_IDX, axis=-1)
    y_ssd = ssd_branch(z, xbc, dt, conv_w, conv_b, dt_bias, a_log, d_skip, ssd_norm_w)
    y_att = swa_branch(q, k, v, g, cos, sin, attn_sinks)
    y = jnp.concatenate([y_ssd, y_att], axis=-1)
    return jnp.einsum("ble,ed->bld", y, w_out)


def setup_inputs(seed: int = 0) -> dict:
    key = jax.random.key(seed)
    ks = jax.random.split(key, 12)
    x = jax.random.normal(ks[0], (BATCH, SEQ, D_MODEL), jnp.float32)
    positions = jnp.broadcast_to(jnp.arange(SEQ, dtype=jnp.int32)[None, :], (BATCH, SEQ))
    col_scale = jnp.ones((D_IN_PROJ,), jnp.float32).at[OFF_V:OFF_V + D_KV].set(BETA)
    w_in = jax.random.normal(ks[1], (DEPTH, D_MODEL, D_IN_PROJ), jnp.float32) * (D_MODEL ** -0.5) * col_scale
    conv_w = jax.random.normal(ks[2], (DEPTH, CONV_K, D_XBC), jnp.float32) * (CONV_K ** -0.5)
    conv_b = 0.01 * jax.random.normal(ks[3], (DEPTH, D_XBC), jnp.float32)
    dt0 = jnp.exp(jax.random.uniform(ks[4], (DEPTH, SSD_HEADS), jnp.float32,
                                     minval=float(np.log(1e-3)), maxval=float(np.log(1e-1))))
    dt_bias = dt0 + jnp.log(-jnp.expm1(-dt0))
    a_log = jnp.log(jax.random.uniform(ks[5], (DEPTH, SSD_HEADS), jnp.float32, minval=1.0, maxval=16.0))
    d_skip = 1.0 + 0.1 * jax.random.normal(ks[6], (DEPTH, SSD_HEADS), jnp.float32)
    ssd_norm_w = 1.0 + 0.02 * jax.random.normal(ks[7], (DEPTH, D_SSD), jnp.float32)
    attn_sinks = 0.5 * jax.random.normal(ks[8], (DEPTH, ATT_Q_HEADS), jnp.float32)
    w_out = jax.random.normal(ks[9], (DEPTH, D_MIX, D_MODEL), jnp.float32) * (D_MIX ** -0.5) * BETA
    ln_g = 1.0 + 0.02 * jax.random.normal(ks[10], (DEPTH, D_MODEL), jnp.float32)
    ln_b = 0.02 * jax.random.normal(ks[11], (DEPTH, D_MODEL), jnp.float32)
    return {"x": x, "positions": positions, "w_in": w_in, "conv_w": conv_w, "conv_b": conv_b,
            "dt_bias": dt_bias, "a_log": a_log, "d_skip": d_skip, "ssd_norm_w": ssd_norm_w,
            "attn_sinks": attn_sinks, "w_out": w_out, "ln_g": ln_g, "ln_b": ln_b}


def reference(x, positions, w_in, conv_w, conv_b, dt_bias, a_log, d_skip, ssd_norm_w,
              attn_sinks, w_out, ln_g, ln_b):
    cos, sin = rope_tables(positions)
    for l in range(DEPTH):
        h = hybrid_mixer(x, cos, sin, w_in[l], conv_w[l], conv_b[l], dt_bias[l], a_log[l],
                         d_skip[l], ssd_norm_w[l], attn_sinks[l], w_out[l])
        x = layer_norm(ALPHA * x + h.astype(x.dtype), ln_g[l], ln_b[l])
    return x
```

```cpp
#include <hip/hip_runtime.h>
#include <cstdio>
#include <cstdint>
#include <cmath>
namespace pg8 {
#define PG8_LAS __attribute__((address_space(3)))
typedef unsigned short bf16_t;
typedef short bf16x8 __attribute__((ext_vector_type(8)));
typedef float f32x4 __attribute__((ext_vector_type(4)));
typedef unsigned u32x4 __attribute__((ext_vector_type(4)));
constexpr int BM = 256, BK = 64, HALF = 128, HTB = HALF * BK * 2  , STAGE_BYTES = 8 * HTB, NXCD = 8, WGM = 8;

__host__ __device__ __forceinline__ int lds_byte(int r, int c) { const int st = (r >> 4) * 2 + (c >> 5), rr = r & 15, cc = c & 31, ob = rr * 64 + cc * 2; return st * 1024 + (ob ^ (((ob >> 9) & 1) << 5)); }
__host__ __device__ __forceinline__ void stage_rc(int b, int& R, int& C) { const int st = b / 1024, sb = b % 1024, swz = sb ^ (((sb >> 9) & 1) << 5); R = (st >> 1) * 16 + swz / 64; C = (st & 1) * 32 + (swz % 64) / 2; }
__host__ __device__ __forceinline__ int perm32(int rho) { const int n = rho >> 4, i = rho & 15; return 8 * (i >> 2) + 4 * n + (i & 3); }

struct Unit { int pm, pn; };
struct Gemm { const bf16_t* A; const bf16_t* Bt; int M, N, K, lda, ldb; };

struct StaticOrder {
    int nM, nN, nwg, G, c;
    __host__ __device__ void init(int M, int N, int G_, int c_) { nM = M / BM; nN = N / BM; nwg = nM * nN; G = G_; c = c_; }
    __host__ __device__ bool next(int i, Unit& u) const {
        const long L = (long)i * G + c; if (L >= nwg) return false;
        int wgid = (int)L; { const int q = nwg / NXCD, r = nwg % NXCD, xcd = wgid % NXCD, off = wgid / NXCD; wgid = (xcd < r ? xcd * (q + 1) : r * (q + 1) + (xcd - r) * q) + off; }
        const int nig = WGM * nN, gid = wgid / nig, fm = gid * WGM, gsz = (nM - fm) < WGM ? (nM - fm) : WGM;
        u.pm = fm + ((wgid % nig) % gsz); u.pn = (wgid % nig) / gsz; return true;
    }
};
struct OneUnitOrder {
    StaticOrder so; int rnd;
    __host__ __device__ bool next(int i, Unit& u) const { if (i != 0) return false; return so.next(rnd, u); }
};

__device__ __forceinline__ unsigned cvt_pk_bf16(float lo, float hi) { unsigned r; asm volatile("v_cvt_pk_bf16_f32 %0, %1, %2" : "=v"(r) : "v"(lo), "v"(hi)); return r; }
struct EpiBf16 {
    static constexpr bool PERM = true, AFTER_DRAIN = false;
    bf16_t* O; int ldc;
    __device__ __forceinline__ void operator()(const f32x4 (&acc)[2][2][4][2], const Unit& u, int wr, int wc, int fr, int fq) const {
        const int row0 = u.pm * BM + wr * 64 + fr; const int col0 = u.pn * BM + wc * 32 + 8 * fq;
#pragma unroll
        for (int ai = 0; ai < 2; ++ai)
#pragma unroll
            for (int m = 0; m < 4; ++m) { bf16_t* rowp = O + (size_t)(row0 + ai * HALF + m * 16) * ldc + col0;
#pragma unroll
                for (int bj = 0; bj < 2; ++bj) { const f32x4 v0 = acc[ai][bj][m][0], v1 = acc[ai][bj][m][1];
                    u32x4 w; w.x = cvt_pk_bf16(v0[0], v0[1]); w.y = cvt_pk_bf16(v0[2], v0[3]); w.z = cvt_pk_bf16(v1[0], v1[1]); w.w = cvt_pk_bf16(v1[2], v1[3]);
                    *(u32x4*)(rowp + bj * HALF) = w; } }
    }
};
struct EpiF32 {
    static constexpr bool PERM = false, AFTER_DRAIN = false;
    float* O; int ldc;
    __device__ __forceinline__ void operator()(const f32x4 (&acc)[2][2][4][2], const Unit& u, int wr, int wc, int fr, int fq) const {
        const int col0 = u.pn * BM + wc * 32 + 4 * fq;
#pragma unroll
        for (int ai = 0; ai < 2; ++ai)
#pragma unroll
            for (int m = 0; m < 4; ++m) { const int r = ai * HALF + wr * 64 + m * 16 + fr; float* rowp = O + (size_t)(u.pm * BM + r) * ldc + col0;
#pragma unroll
                for (int bj = 0; bj < 2; ++bj)
#pragma unroll
                    for (int n = 0; n < 2; ++n) *(f32x4*)(rowp + bj * HALF + n * 16) = acc[ai][bj][m][n]; }
    }
};
template <class Epi, class Sched, bool ALIGN_EPI = false, bool SP2 = false>
__device__ __forceinline__ void gemm_phase(PG8_LAS unsigned char* lds, const Gemm g, const Sched& S, const Epi& E) {
    const int tid = threadIdx.x, wid = __builtin_amdgcn_readfirstlane(tid >> 6), lane = tid & 63, wr = wid >> 2, wc = wid & 3, fr = lane & 15, fq = lane >> 4;
    const int K = g.K, nt = K / BK;
    unsigned voffA[2], voffB[2];
#pragma unroll
    for (int i = 0; i < 2; ++i) { int R, C; stage_rc(tid * 16 + i * 8192, R, C); const int Rb = Epi::PERM ? ((R & ~31) + perm32(R & 31)) : R;
        voffA[i] = (unsigned)(R * g.lda + C) * 2u; voffB[i] = (unsigned)(Rb * g.ldb + C) * 2u; }
    const size_t kstep = (size_t)(BK * 2);
    const size_t hstepA = (size_t)HALF * g.lda * 2, hstepB = (size_t)HALF * g.ldb * 2;
    const size_t tstepA = 2 * hstepA, tstepB = 2 * hstepB;
    const unsigned ldsw = (unsigned)wid * 1024u;
    const int aoff = lds_byte(wr * 64 + fr, fq * 8), boff = lds_byte(wc * 32 + fr, fq * 8);
#define PG8_SA(b, h) (((b) * 2 + (h)) * HTB)
#define PG8_SB(b, h) ((4 + (b) * 2 + (h)) * HTB)
#define PG8_STAGE(bufoff, gbase, voff) do { _Pragma("unroll") for (int _i = 0; _i < 2; ++_i) \
        __builtin_amdgcn_global_load_lds((const unsigned*)((const char*)(gbase) + (voff)[_i]), (PG8_LAS unsigned*)(lds + (bufoff) + ldsw + _i * 8192), 16, 0, 0); } while (0)
#define PG8_LDA(dst, b, h) do { _Pragma("unroll") for (int m = 0; m < 4; ++m) _Pragma("unroll") for (int k = 0; k < 2; ++k) dst[m][k] = *(const PG8_LAS bf16x8*)(lds + PG8_SA(b, h) + aoff + m * 2048 + k * 1024); } while (0)
#define PG8_LDB(dst, b, h) do { _Pragma("unroll") for (int n = 0; n < 2; ++n) _Pragma("unroll") for (int k = 0; k < 2; ++k) dst[n][k] = *(const PG8_LAS bf16x8*)(lds + PG8_SB(b, h) + boff + n * 2048 + k * 1024); } while (0)
#define PG8_MMA(ai, bj, At, Bt) do { __builtin_amdgcn_s_setprio(1); _Pragma("unroll") for (int m = 0; m < 4; ++m) _Pragma("unroll") for (int n = 0; n < 2; ++n) _Pragma("unroll") for (int k = 0; k < 2; ++k) \
        acc[ai][bj][m][n] = __builtin_amdgcn_mfma_f32_16x16x32_bf16(Bt[n][k], At[m][k], acc[ai][bj][m][n], 0, 0, 0); __builtin_amdgcn_s_setprio(0); } while (0)
#define PG8_WAIT_V(n) asm volatile("s_waitcnt vmcnt(" #n ")" ::: "memory")
#define PG8_WAIT_L(n) asm volatile("s_waitcnt lgkmcnt(" #n ")" ::: "memory")
#define PG8_BAR __builtin_amdgcn_s_barrier()
#define PG8_SCHED __builtin_amdgcn_sched_barrier(0)
    Unit cur, nxt; int ui = 0;
    if (!S.next(0, cur)) return;
    f32x4 acc[2][2][4][2];
#pragma unroll
    for (int a = 0; a < 2; ++a)
#pragma unroll
        for (int b = 0; b < 2; ++b)
#pragma unroll
            for (int m = 0; m < 4; ++m)
#pragma unroll
                for (int n = 0; n < 2; ++n) acc[a][b][m][n] = (f32x4){0.f, 0.f, 0.f, 0.f};
    bf16x8 At[4][2], B0[2][2], B1[2][2];
    const char* cA = (const char*)g.A + (size_t)cur.pm * tstepA; const char* cB = (const char*)g.Bt + (size_t)cur.pn * tstepB;
    if constexpr (SP2) {
        PG8_STAGE(PG8_SB(0, 0), cB, voffB); PG8_STAGE(PG8_SB(0, 1), cB + hstepB, voffB); PG8_STAGE(PG8_SA(0, 0), cA, voffA); PG8_STAGE(PG8_SA(0, 1), cA + hstepA, voffA);
        if (wr == 1) PG8_BAR;
        PG8_WAIT_V(2); PG8_BAR;
        PG8_STAGE(PG8_SB(1, 0), cB + kstep, voffB); PG8_STAGE(PG8_SA(1, 0), cA + kstep, voffA); PG8_STAGE(PG8_SB(1, 1), cB + hstepB + kstep, voffB);
        PG8_WAIT_V(6); PG8_BAR;
    } else {
        PG8_STAGE(PG8_SB(0, 0), cB, voffB); PG8_STAGE(PG8_SA(0, 0), cA, voffA); PG8_STAGE(PG8_SB(0, 1), cB + hstepB, voffB); PG8_STAGE(PG8_SA(0, 1), cA + hstepA, voffA);
        if (wr == 1) PG8_BAR;
        PG8_WAIT_V(4); PG8_BAR;
        PG8_STAGE(PG8_SB(1, 0), cB + kstep, voffB); PG8_STAGE(PG8_SA(1, 0), cA + kstep, voffA); PG8_STAGE(PG8_SB(1, 1), cB + hstepB + kstep, voffB);
        PG8_WAIT_V(6); PG8_BAR;
    }
    for (;;) {
        const bool has_next = S.next(ui + 1, nxt);
        const char* nA = has_next ? (const char*)g.A + (size_t)nxt.pm * tstepA : cA; const char* nB = has_next ? (const char*)g.Bt + (size_t)nxt.pn * tstepB : cB;
        for (int t = 0; t < nt; t += 2) {
            const bool last = (t == nt - 2);
            const char* a1 = cA + (size_t)(t + 1) * kstep;
            const char* a2 = last ? nA : cA + (size_t)(t + 2) * kstep; const char* b2 = last ? nB : cB + (size_t)(t + 2) * kstep;
            const char* a3 = a2 + kstep; const char* b3 = b2 + kstep;
            if constexpr (SP2) {
            PG8_LDB(B0, 0, 0); PG8_LDB(B1, 0, 1); PG8_SCHED; PG8_LDA(At, 0, 0); PG8_STAGE(PG8_SA(1, 1), a1 + hstepA, voffA);
            PG8_WAIT_V(8); PG8_WAIT_L(0); PG8_BAR; PG8_MMA(0, 0, At, B0); PG8_MMA(0, 1, At, B1); PG8_BAR; PG8_SCHED;
            PG8_LDA(At, 0, 1); PG8_STAGE(PG8_SB(0, 0), b2, voffB); PG8_STAGE(PG8_SB(0, 1), b2 + hstepB, voffB); PG8_STAGE(PG8_SA(0, 0), a2, voffA);
            PG8_WAIT_V(8); PG8_WAIT_L(0); PG8_BAR; PG8_MMA(1, 0, At, B0); PG8_MMA(1, 1, At, B1); PG8_BAR; PG8_SCHED;
            PG8_LDB(B0, 1, 0); PG8_LDB(B1, 1, 1); PG8_SCHED; PG8_LDA(At, 1, 0); PG8_STAGE(PG8_SA(0, 1), a2 + hstepA, voffA);
            PG8_WAIT_V(8); PG8_WAIT_L(0); PG8_BAR; PG8_MMA(0, 0, At, B0); PG8_MMA(0, 1, At, B1); PG8_BAR; PG8_SCHED;
            PG8_LDA(At, 1, 1); PG8_STAGE(PG8_SB(1, 0), b3, voffB); PG8_STAGE(PG8_SB(1, 1), b3 + hstepB, voffB); PG8_STAGE(PG8_SA(1, 0), a3, voffA);
            PG8_WAIT_V(8); PG8_WAIT_L(0); PG8_BAR; PG8_MMA(1, 0, At, B0); PG8_MMA(1, 1, At, B1); PG8_BAR; PG8_SCHED;
            } else {
            PG8_LDB(B0, 0, 0); PG8_SCHED; PG8_LDA(At, 0, 0); PG8_STAGE(PG8_SA(1, 1), a1 + hstepA, voffA);
            PG8_WAIT_L(8); PG8_BAR; PG8_WAIT_L(0); PG8_MMA(0, 0, At, B0); PG8_BAR; PG8_SCHED;
            PG8_LDB(B1, 0, 1); PG8_STAGE(PG8_SB(0, 0), b2, voffB);
            PG8_BAR; PG8_WAIT_L(0); PG8_MMA(0, 1, At, B1); PG8_BAR;
            PG8_LDA(At, 0, 1); PG8_STAGE(PG8_SA(0, 0), a2, voffA);
            PG8_BAR; PG8_WAIT_L(0); PG8_MMA(1, 0, At, B0); PG8_BAR; PG8_SCHED;
            PG8_STAGE(PG8_SB(0, 1), b2 + hstepB, voffB);
            PG8_WAIT_V(6); PG8_BAR; PG8_MMA(1, 1, At, B1); PG8_BAR;
            PG8_LDB(B0, 1, 0); PG8_SCHED; PG8_LDA(At, 1, 0); PG8_STAGE(PG8_SA(0, 1), a2 + hstepA, voffA);
            PG8_WAIT_L(8); PG8_BAR; PG8_WAIT_L(0); PG8_MMA(0, 0, At, B0); PG8_BAR; PG8_SCHED;
            PG8_LDB(B1, 1, 1); PG8_STAGE(PG8_SB(1, 0), b3, voffB);
            PG8_BAR; PG8_WAIT_L(0); PG8_MMA(0, 1, At, B1); PG8_BAR;
            PG8_LDA(At, 1, 1); PG8_STAGE(PG8_SA(1, 0), a3, voffA);
            PG8_BAR; PG8_WAIT_L(0); PG8_MMA(1, 0, At, B0); PG8_BAR; PG8_SCHED;
            PG8_STAGE(PG8_SB(1, 1), b3 + hstepB, voffB);
            PG8_WAIT_V(6); PG8_BAR; PG8_MMA(1, 1, At, B1); PG8_BAR;
            }
        }
        if constexpr (ALIGN_EPI) { if (wr == 0) PG8_BAR; }
        if constexpr (!Epi::AFTER_DRAIN) { E(acc, cur, wr, wc, fr, fq); }
        if (!has_next) break;
#pragma unroll
        for (int a = 0; a < 2; ++a)
#pragma unroll
            for (int b = 0; b < 2; ++b)
#pragma unroll
                for (int m = 0; m < 4; ++m)
#pragma unroll
                    for (int n = 0; n < 2; ++n) acc[a][b][m][n] = (f32x4){0.f, 0.f, 0.f, 0.f};
        cur = nxt; cA = nA; cB = nB; ++ui;
        if constexpr (ALIGN_EPI) { if (wr == 1) PG8_BAR; }
    }
    PG8_WAIT_V(0);
    if constexpr (!ALIGN_EPI) { if (wr == 0) PG8_BAR; }
    PG8_BAR;
    if constexpr (Epi::AFTER_DRAIN) { E.fused(acc, cur, wr, wc, fr, fq, lds, wid, lane); }
#undef PG8_SA
#undef PG8_SB
#undef PG8_STAGE
#undef PG8_LDA
#undef PG8_LDB
#undef PG8_MMA
#undef PG8_WAIT_V
#undef PG8_WAIT_L
#undef PG8_BAR
#undef PG8_SCHED
}
}
constexpr int BATCH = 8, SEQ = 4096, DMODEL = 1024, MTOK = BATCH * SEQ;
constexpr int NH = 16, HD = 64, NST = 128, DXBC = 1536;
constexpr int DIN = 5136, OFF_XBC = 1024, OFF_DT = 2560, OFF_Q = 2576, OFF_K = 3600, OFF_V = 3856, OFF_G = 4112;
constexpr int LDP = 5120, PC_Z = 0, PC_Q = 1024, PC_XBC = 2048, PC_K = 3584, PC_V = 3840, PC_G = 4096;
constexpr float ALPHA = 1.189207115002721f, LN_EPS = 1e-5f, RMS_EPS = 1e-5f;
constexpr float LOG2E = 1.4426950408889634f, C2 = 0.125f * LOG2E;

constexpr size_t MiB = 1u << 20;
constexpr size_t WS_CTL = 0, CTL_ZERO_BYTES = 1 * MiB;
constexpr size_t WS_WIN = 1 * MiB;
constexpr size_t WS_WOUT = 11 * MiB;
constexpr size_t WS_COS = 15 * MiB, WS_SIN = 16 * MiB;
constexpr size_t WS_DT = 17 * MiB;
constexpr size_t WS_SSQ = 19 * MiB;
constexpr size_t WS_XB = 24 * MiB;
constexpr size_t WS_PROJ = 88 * MiB;
constexpr size_t WS_XC = 408 * MiB;
constexpr size_t WS_END = 504 * MiB;

constexpr int CW_TMO = 0, CW_CODE = 1, CW_BAR = 4096;

constexpr int NWAVES = 8, NTHREADS = 512;
constexpr int RING_BYTES = 131072, LDSCTL_OFF = RING_BYTES, MISC_OFF = LDSCTL_OFF + 320, LDS_BYTES = 147456;

#define GAS __attribute__((address_space(1)))
#define LAS __attribute__((address_space(3)))
typedef unsigned short bf16;
typedef unsigned v4u __attribute__((ext_vector_type(4)));
typedef unsigned v2u __attribute__((ext_vector_type(2)));
typedef float f32x4 __attribute__((ext_vector_type(4)));
typedef GAS unsigned gu32;
#define RLX_AGENT __ATOMIC_RELAXED, __HIP_MEMORY_SCOPE_AGENT
#define LDS_WAIT() asm volatile("s_waitcnt lgkmcnt(0)" ::: "memory")
#define VM_WAIT() asm volatile("s_waitcnt vmcnt(0)" ::: "memory")
__device__ __forceinline__ unsigned f2bf(float f) { unsigned u = __builtin_bit_cast(unsigned, f); return (u + 0x7fffu + ((u >> 16) & 1u)) >> 16; }
__device__ __forceinline__ unsigned pk2(float lo, float hi) { return f2bf(lo) | (f2bf(hi) << 16); }
__device__ __forceinline__ float bf2f(unsigned u16) { return __builtin_bit_cast(float, u16 << 16); }
__device__ __forceinline__ float bflo(unsigned w) { return __builtin_bit_cast(float, w << 16); }
__device__ __forceinline__ float bfhi(unsigned w) { return __builtin_bit_cast(float, w & 0xffff0000u); }
__device__ __forceinline__ float wave_sum(float v) {
#pragma unroll
    for (int o = 1; o < 64; o <<= 1) v += __shfl_xor(v, o);
    return v;
}
__device__ __forceinline__ float silu_f(float v) { return v * __builtin_amdgcn_rcpf(1.f + __expf(-v)); }

#define XB_TMO      128
#define XB_XCNT(j)  (256  + 64 * (j))
#define XB_XSUB(j)  (1280 + 64 * (j))
#define XB_XGEN(j)  (2304 + 64 * (j))
#define XB_TOP      3328
#define XB_TOPGEN   3392
#define XCD_BAR_WORDS 3456
#define XB_SPIN_CAP (1u << 18)
__device__ __forceinline__ unsigned xb_ld(unsigned* p)              { return __hip_atomic_load(p, __ATOMIC_RELAXED, __HIP_MEMORY_SCOPE_AGENT); }
__device__ __forceinline__ unsigned xb_add(unsigned* p, unsigned v) { return __hip_atomic_fetch_add(p, v, __ATOMIC_RELAXED, __HIP_MEMORY_SCOPE_AGENT); }
__device__ __forceinline__ unsigned xb_xcc_id() { return (unsigned)__builtin_amdgcn_s_getreg((3 << 11) | 20) & 0xFu; }
#define XB_SPIN(cond, bar) do { unsigned _sp = 0; while (cond) { __builtin_amdgcn_s_sleep(1); \
    if ((++_sp & 255u) == 0u) { if (xb_ld(&(bar)[XB_TMO])) break; if (_sp > XB_SPIN_CAP) { atomicAdd(&(bar)[XB_TMO], 1u); break; } } } } while (0)
struct XcdBarrier { unsigned* bar; unsigned x; volatile LAS unsigned* st; };
__device__ __forceinline__ XcdBarrier xcd_barrier_post(unsigned* bar, volatile LAS unsigned* st) {
    XcdBarrier b; b.bar = bar; b.x = xb_xcc_id(); b.st = st;
    if (threadIdx.x == 0) (void)xb_add(&bar[XB_XCNT(b.x)], 1u);
    return b;
}
__device__ __forceinline__ void xcd_barrier_complete(unsigned* bar, unsigned x, unsigned& nloc, unsigned& nx) {
    const unsigned G = gridDim.x * gridDim.y * gridDim.z;
    unsigned sum, cnt, mine, sp = 0u;
    for (;;) {
        sum = 0u; cnt = 0u; mine = 0u;
#pragma unroll
        for (unsigned j = 0; j < 16; ++j) { const unsigned c = xb_ld(&bar[XB_XCNT(j)]); sum += c; cnt += (c > 0u) ? 1u : 0u; mine = (j == x) ? c : mine; }
        if (sum == G) break;
        __builtin_amdgcn_s_sleep(1);
        if ((++sp & 255u) == 0u) { if (xb_ld(&bar[XB_TMO])) break; if (sp > XB_SPIN_CAP) { atomicAdd(&bar[XB_TMO], 1u); break; } }
    }
    nloc = mine > 0u ? mine : 1u; nx = cnt > 0u ? cnt : 1u;
}
__device__ __forceinline__ void xcd_barrier(const XcdBarrier& b) {
    asm volatile("s_waitcnt vmcnt(0)" ::: "memory");
    __syncthreads();
    if (threadIdx.x == 0) {
        unsigned* bar = b.bar;
        __builtin_amdgcn_s_waitcnt(0);
        unsigned nloc = b.st[0], nx = b.st[1];
        if (nloc == 0u) { xcd_barrier_complete(bar, b.x, nloc, nx); b.st[0] = nloc; b.st[1] = nx; }
        const unsigned old = xb_add(&bar[XB_XSUB(b.x)], 1u);
        const unsigned gen = old / nloc;
        if (old + 1u == (gen + 1u) * nloc) {
            __builtin_amdgcn_fence(__ATOMIC_RELEASE, "agent");
            asm volatile("s_waitcnt vmcnt(0)" ::: "memory");
            const unsigned og = xb_add(&bar[XB_TOP], 1u);
            const unsigned tg = og / nx;
            if (og + 1u == (tg + 1u) * nx) xb_add(&bar[XB_TOPGEN], 1u);
            else XB_SPIN(xb_ld(&bar[XB_TOPGEN]) == tg, bar);
            __builtin_amdgcn_fence(__ATOMIC_ACQUIRE, "agent");
            xb_add(&bar[XB_XGEN(b.x)], 1u);
            asm volatile("s_waitcnt vmcnt(0)" ::: "memory");
        } else {
            XB_SPIN(xb_ld(&bar[XB_XGEN(b.x)]) == gen, bar);
            __builtin_amdgcn_fence(__ATOMIC_ACQUIRE, "agent");
            asm volatile("s_waitcnt vmcnt(0)" ::: "memory");
        }
    }
    __syncthreads();
}

struct Args {
    const float* x; const int* pos; const float* w_in; const float* conv_w; const float* conv_b; const float* dt_bias; const float* a_log;
    const float* d_skip; const float* norm_w; const float* sinks; const float* w_out; const float* ln_g; const float* ln_b;
    float* out; unsigned char* ws; int ph_lo, ph_hi;
};
struct Frame {
    LAS unsigned char* lds; int tid, lane, wave, vcu, G;
    bf16 *w_in_t, *w_out_t, *xb, *proj, *xc; float *cosT, *sinT, *dt, *ssq;
};

__device__ __forceinline__ int win_src_col(int n) {
    if (n < 1024) return n; if (n < 2048) return OFF_Q + n - 1024; if (n < 3584) return OFF_XBC + n - 2048;
    if (n < 3840) return OFF_K + n - 3584; if (n < 4096) return OFF_V + n - 3840; return OFF_G + n - 4096;
}
__device__ __forceinline__ void transpose_item(const float* W, int ldw, int srccol0, float scale, bf16* WT, int ldk, int n0, int k0, LAS float* scr, int lane) {
#pragma unroll 8
    for (int i = 0; i < 32; ++i) { const int kk = 2 * i + (lane >> 5); scr[kk * 33 + (lane & 31)] = W[(size_t)(k0 + kk) * ldw + srccol0 + (lane & 31)] * scale; }
    LDS_WAIT(); asm volatile("" ::: "memory");
    const int c = lane & 7;
#pragma unroll
    for (int j = 0; j < 4; ++j) { const int n = (lane >> 3) + 8 * j; const LAS float* s = scr + (8 * c) * 33 + n;
        v4u o; o.x = pk2(s[0 * 33], s[1 * 33]); o.y = pk2(s[2 * 33], s[3 * 33]); o.z = pk2(s[4 * 33], s[5 * 33]); o.w = pk2(s[6 * 33], s[7 * 33]);
        *(GAS v4u*)(WT + (size_t)(n0 + n) * ldk + k0 + 8 * c) = o; }
    LDS_WAIT(); asm volatile("" ::: "memory");
}
__device__ __forceinline__ void p0_prologue(const Args& a, Frame& F) {
    LAS float* scr = (LAS float*)(F.lds + F.wave * 8448);
    const int gw = F.vcu * NWAVES + F.wave, NGW = F.G * NWAVES;
    constexpr int I_IN = (1024 / 64) * (5120 / 32), I_OUT = (2048 / 64) * (1024 / 32);
    for (int it = gw; it < I_IN + I_OUT; it += NGW) {
        if (it < I_IN) { const int nblk = 5120 / 32, kb = it / nblk, nb = it % nblk, n0 = 32 * nb;
            transpose_item(a.w_in, DIN, win_src_col(n0), (n0 >= 1024 && n0 < 2048) ? C2 : 1.0f, F.w_in_t, 1024, n0, 64 * kb, scr, F.lane); }
        else { const int r = it - I_IN, nblk = 1024 / 32, kb = r / nblk, nb = r % nblk;
            transpose_item(a.w_out, 1024, 32 * nb, 1.0f, F.w_out_t, 2048, 32 * nb, 64 * kb, scr, F.lane); }
    }
    __syncthreads();
    LAS float* wdt = (LAS float*)(F.lds);
    for (int i = F.tid; i < 16 * 1024; i += NTHREADS) { const int k = i >> 4, h = i & 15; wdt[h * 1024 + k] = a.w_in[(size_t)k * DIN + OFF_DT + h]; }
    __syncthreads();
    const int lane = F.lane;
    float myb = a.dt_bias[lane >> 2];
    for (int m = gw; m < MTOK; m += NGW) {
        const GAS f32x4* xr = (const GAS f32x4*)(a.x + (size_t)m * DMODEL) + lane;
        f32x4 v[4];
#pragma unroll
        for (int j = 0; j < 4; ++j) v[j] = xr[64 * j];
        GAS unsigned long long* o8 = (GAS unsigned long long*)(F.xb + (size_t)m * DMODEL) + lane;
#pragma unroll
        for (int j = 0; j < 4; ++j) o8[64 * j] = (unsigned long long)pk2(v[j].x, v[j].y) | ((unsigned long long)pk2(v[j].z, v[j].w) << 32);
        float acc[16];
#pragma unroll
        for (int h = 0; h < 16; ++h) { float s = 0.f;
#pragma unroll
            for (int j = 0; j < 4; ++j) { const f32x4 w = *(const LAS f32x4*)(wdt + h * 1024 + 256 * j + 4 * lane); s += (v[j].x * w.x + v[j].y * w.y) + (v[j].z * w.z + v[j].w * w.w); }
            acc[h] = s; if (h & 1) asm volatile("" ::: "memory"); }
        float r8[8], r4[4], r2[2], r1;
        const bool b5 = lane & 32, b4 = lane & 16, b3 = lane & 8, b2 = lane & 4;
#pragma unroll
        for (int i = 0; i < 8; ++i) { const float snd = b5 ? acc[i] : acc[i + 8], kp = b5 ? acc[i + 8] : acc[i]; r8[i] = kp + __shfl_xor(snd, 32); }
#pragma unroll
        for (int i = 0; i < 4; ++i) { const float snd = b4 ? r8[i] : r8[i + 4], kp = b4 ? r8[i + 4] : r8[i]; r4[i] = kp + __shfl_xor(snd, 16); }
#pragma unroll
        for (int i = 0; i < 2; ++i) { const float snd = b3 ? r4[i] : r4[i + 2], kp = b3 ? r4[i + 2] : r4[i]; r2[i] = kp + __shfl_xor(snd, 8); }
        { const float snd = b2 ? r2[0] : r2[1], kp = b2 ? r2[1] : r2[0]; r1 = kp + __shfl_xor(snd, 4); }
        r1 += __shfl_xor(r1, 1); r1 += __shfl_xor(r1, 2);
        const float pre = r1 + myb;
        const float dtv = pre > 20.f ? pre : log1pf(expf(pre));
        if ((lane & 3) == 0) F.dt[(size_t)m * 16 + (lane >> 2)] = dtv;
    }
    const int gt = F.vcu * NTHREADS + F.tid, GT = F.G * NTHREADS;
    for (int idx = gt; idx < MTOK * 8; idx += GT) {
        const int m = idx >> 3, i = idx & 7;
        const float inv = exp2f(-(float)i * 2.366446071165522f);
        const float ang = (float)a.pos[m] * inv;
        double rev = (double)ang * 0.15915494309189535; rev -= __builtin_rint(rev);
        F.cosT[idx] = __builtin_amdgcn_cosf((float)rev); F.sinT[idx] = __builtin_amdgcn_sinf((float)rev);
    }
}

__device__ __forceinline__ void p_rope(Frame& F) {
    const int gt = F.vcu * NTHREADS + F.tid, GT = F.G * NTHREADS;
    for (int item = gt; item < MTOK * 160; item += GT) {
        const int i = item & 7, hd = (item >> 3) % 20, m = item / 160;
        const int col = hd < 16 ? PC_Q + hd * 64 : PC_K + (hd - 16) * 64;
        bf16* p = F.proj + (size_t)m * LDP + col;
        const float r1 = bf2f(p[i]), r2 = bf2f(p[i + 8]), c = F.cosT[m * 8 + i], s = F.sinT[m * 8 + i];
        p[i] = (bf16)f2bf(r1 * c - r2 * s); p[i + 8] = (bf16)f2bf(r2 * c + r1 * s);
    }
}
__device__ __forceinline__ void p_conv(const Args& a, Frame& F) {
    const int gt = F.vcu * NTHREADS + F.tid, GT = F.G * NTHREADS;
    for (int item = gt; item < (MTOK / 16) * 192; item += GT) {
        const int cg = item % 192, rb = item / 192, r0 = rb * 16, ch = cg * 8;
        float w[4][8], bias[8], win[3][8];
#pragma unroll
        for (int k = 0; k < 4; ++k) { const f32x4 w0 = *(const f32x4*)(a.conv_w + k * DXBC + ch), w1 = *(const f32x4*)(a.conv_w + k * DXBC + ch + 4);
            w[k][0] = w0.x; w[k][1] = w0.y; w[k][2] = w0.z; w[k][3] = w0.w; w[k][4] = w1.x; w[k][5] = w1.y; w[k][6] = w1.z; w[k][7] = w1.w; }
        { const f32x4 b0 = *(const f32x4*)(a.conv_b + ch), b1 = *(const f32x4*)(a.conv_b + ch + 4);
            bias[0] = b0.x; bias[1] = b0.y; bias[2] = b0.z; bias[3] = b0.w; bias[4] = b1.x; bias[5] = b1.y; bias[6] = b1.z; bias[7] = b1.w; }
        const bool seq_start = (r0 & (SEQ - 1)) == 0;
#pragma unroll
        for (int k = 0; k < 3; ++k) {
            v4u q = (v4u){0u, 0u, 0u, 0u};
            if (!seq_start) q = *(const GAS v4u*)(F.proj + (size_t)(r0 - 3 + k) * LDP + PC_XBC + ch);
            win[k][0] = bflo(q.x); win[k][1] = bfhi(q.x); win[k][2] = bflo(q.y); win[k][3] = bfhi(q.y); win[k][4] = bflo(q.z); win[k][5] = bfhi(q.z); win[k][6] = bflo(q.w); win[k][7] = bfhi(q.w);
        }
#pragma unroll
        for (int r = 0; r < 16; ++r) {
            const v4u q = *(const GAS v4u*)(F.proj + (size_t)(r0 + r) * LDP + PC_XBC + ch);
            float cur[8] = {bflo(q.x), bfhi(q.x), bflo(q.y), bfhi(q.y), bflo(q.z), bfhi(q.z), bflo(q.w), bfhi(q.w)};
            float o[8];
#pragma unroll
            for (int e = 0; e < 8; ++e) { const float s = bias[e] + w[0][e] * win[0][e] + w[1][e] * win[1][e] + w[2][e] * win[2][e] + w[3][e] * cur[e]; o[e] = silu_f(s); }
            v4u ov; ov.x = pk2(o[0], o[1]); ov.y = pk2(o[2], o[3]); ov.z = pk2(o[4], o[5]); ov.w = pk2(o[6], o[7]);
            *(GAS v4u*)(F.xc + (size_t)(r0 + r) * DXBC + ch) = ov;
#pragma unroll
            for (int e = 0; e < 8; ++e) { win[0][e] = win[1][e]; win[1][e] = win[2][e]; win[2][e] = cur[e]; }
        }
    }
}
__device__ __forceinline__ void p_ssd_naive(const Args& a, Frame& F, float* yout) {
    LAS float* Bs = (LAS float*)F.lds; LAS float* Cs = Bs + 64 * 128; LAS float* xs = Cs + 64 * 128; LAS float* dts = xs + 64 * 64;
    const int tid = F.tid, p = tid >> 3, nq = tid & 7;
    for (int bh = F.vcu; bh < BATCH * NH; bh += F.G) {
        const int b = bh / NH, h = bh % NH, g = h >> 3;
        const float A = -expf(a.a_log[h]), Dk = a.d_skip[h];
        float st[16];
#pragma unroll
        for (int i = 0; i < 16; ++i) st[i] = 0.f;
        for (int c0 = 0; c0 < SEQ; c0 += 64) {
            __syncthreads();
            const size_t row0 = (size_t)b * SEQ + c0;
            for (int i = tid; i < 64 * 16; i += NTHREADS) { const int r = i >> 4, c8 = (i & 15) * 8;
                const v4u qb = *(const GAS v4u*)(F.xc + (row0 + r) * DXBC + 1024 + g * 128 + c8), qc = *(const GAS v4u*)(F.xc + (row0 + r) * DXBC + 1280 + g * 128 + c8);
                LAS float* bd = Bs + r * 128 + c8; LAS float* cd = Cs + r * 128 + c8;
                bd[0] = bflo(qb.x); bd[1] = bfhi(qb.x); bd[2] = bflo(qb.y); bd[3] = bfhi(qb.y); bd[4] = bflo(qb.z); bd[5] = bfhi(qb.z); bd[6] = bflo(qb.w); bd[7] = bfhi(qb.w);
                cd[0] = bflo(qc.x); cd[1] = bfhi(qc.x); cd[2] = bflo(qc.y); cd[3] = bfhi(qc.y); cd[4] = bflo(qc.z); cd[5] = bfhi(qc.z); cd[6] = bflo(qc.w); cd[7] = bfhi(qc.w); }
            { const int r = tid >> 3, c8 = (tid & 7) * 8; const v4u qx = *(const GAS v4u*)(F.xc + (row0 + r) * DXBC + h * 64 + c8); LAS float* xd = xs + r * 64 + c8;
                xd[0] = bflo(qx.x); xd[1] = bfhi(qx.x); xd[2] = bflo(qx.y); xd[3] = bfhi(qx.y); xd[4] = bflo(qx.z); xd[5] = bfhi(qx.z); xd[6] = bflo(qx.w); xd[7] = bfhi(qx.w); }
            if (tid < 64) dts[tid] = F.dt[(row0 + tid) * 16 + h];
            __syncthreads();
            for (int r = 0; r < 64; ++r) {
                const float dtv = dts[r], dA = expf(dtv * A), xp = xs[r * 64 + p], xdt = xp * dtv;
                float part = 0.f;
#pragma unroll
                for (int q4 = 0; q4 < 4; ++q4) { const f32x4 bv = *(const LAS f32x4*)(Bs + r * 128 + nq * 16 + 4 * q4), cv = *(const LAS f32x4*)(Cs + r * 128 + nq * 16 + 4 * q4);
                    st[4 * q4 + 0] = st[4 * q4 + 0] * dA + xdt * bv.x; part += st[4 * q4 + 0] * cv.x;
                    st[4 * q4 + 1] = st[4 * q4 + 1] * dA + xdt * bv.y; part += st[4 * q4 + 1] * cv.y;
                    st[4 * q4 + 2] = st[4 * q4 + 2] * dA + xdt * bv.z; part += st[4 * q4 + 2] * cv.z;
                    st[4 * q4 + 3] = st[4 * q4 + 3] * dA + xdt * bv.w; part += st[4 * q4 + 3] * cv.w; }
                part += __shfl_xor(part, 1); part += __shfl_xor(part, 2); part += __shfl_xor(part, 4);
                if (nq == 0) yout[(row0 + r) * 1024 + h * 64 + p] = part + Dk * xp;
            }
        }
    }
}
__device__ __forceinline__ void p_gate_norm(const Args& a, Frame& F, const float* yin) {
    const int gw = F.vcu * NWAVES + F.wave, NGW = F.G * NWAVES, lane = F.lane;
    for (int m = gw; m < MTOK; m += NGW) {
        const GAS f32x4* yr = (const GAS f32x4*)(yin + (size_t)m * 1024) + lane;
        GAS v2u* zr = (GAS v2u*)(F.proj + (size_t)m * LDP + PC_Z) + lane;
        float yg[16]; float ss0 = 0.f, ss1 = 0.f;
#pragma unroll
        for (int j = 0; j < 4; ++j) { const f32x4 yv = yr[64 * j]; const v2u zq = zr[64 * j];
            const float z0 = bflo(zq.x), z1 = bfhi(zq.x), z2 = bflo(zq.y), z3 = bfhi(zq.y);
            yg[4 * j + 0] = yv.x * silu_f(z0); yg[4 * j + 1] = yv.y * silu_f(z1); yg[4 * j + 2] = yv.z * silu_f(z2); yg[4 * j + 3] = yv.w * silu_f(z3);
            const float q = (yg[4 * j] * yg[4 * j] + yg[4 * j + 1] * yg[4 * j + 1]) + (yg[4 * j + 2] * yg[4 * j + 2] + yg[4 * j + 3] * yg[4 * j + 3]);
            if (j < 2) ss0 += q; else ss1 += q; }
        ss0 = wave_sum(ss0); ss1 = wave_sum(ss1);
        const float r0 = 1.f / sqrtf(ss0 * (1.f / 512.f) + RMS_EPS), r1 = 1.f / sqrtf(ss1 * (1.f / 512.f) + RMS_EPS);
#pragma unroll
        for (int j = 0; j < 4; ++j) { const f32x4 nw = *(const f32x4*)(a.norm_w + 256 * j + 4 * lane); const float rr = j < 2 ? r0 : r1;
            v2u o; o.x = pk2(yg[4 * j] * rr * nw.x, yg[4 * j + 1] * rr * nw.y); o.y = pk2(yg[4 * j + 2] * rr * nw.z, yg[4 * j + 3] * rr * nw.w); zr[64 * j] = o; }
    }
}
__device__ __forceinline__ void p_attn_naive(const Args& a, Frame& F) {
    const int gw = F.vcu * NWAVES + F.wave, NGW = F.G * NWAVES, lane = F.lane;
    for (int item = gw; item < MTOK * 16; item += NGW) {
        const int hq = item & 15, t = item >> 4, tl = t & (SEQ - 1), kvh = hq >> 2;
        bf16* qp = F.proj + (size_t)t * LDP + PC_Q + hq * 64 + lane;
        const float q = bf2f(*qp);
        float m2 = a.sinks[hq] * LOG2E, l = 1.f, acc = 0.f;
        const int nk = tl < 127 ? tl + 1 : 128;
        const bf16* kp = F.proj + (size_t)(t - nk + 1) * LDP + PC_K + kvh * 64 + lane;
        for (int j = 0; j < nk; ++j) {
            const float kv = bf2f(kp[(size_t)j * LDP]), vv = bf2f(kp[(size_t)j * LDP + (PC_V - PC_K)]);
            const float s = wave_sum(q * kv);
            const float mn = fmaxf(m2, s), f = exp2f(m2 - mn), pp = exp2f(s - mn);
            l = l * f + pp; acc = acc * f + pp * vv; m2 = mn;
        }
        const float gv = bf2f(F.proj[(size_t)t * LDP + PC_G + hq * 64 + lane]);
        *qp = (bf16)f2bf(acc / l * silu_f(gv));
    }
}
__device__ __forceinline__ void p_ln(const Args& a, Frame& F) {
    const int gw = F.vcu * NWAVES + F.wave, NGW = F.G * NWAVES, lane = F.lane;
    for (int m = gw; m < MTOK; m += NGW) {
        const GAS f32x4* xr = (const GAS f32x4*)(a.x + (size_t)m * DMODEL) + lane;
        GAS f32x4* hr = (GAS f32x4*)(a.out + (size_t)m * DMODEL) + lane;
        f32x4 v[4]; float s = 0.f;
#pragma unroll
        for (int j = 0; j < 4; ++j) { v[j] = xr[64 * j] * ALPHA + hr[64 * j]; s += (v[j].x + v[j].y) + (v[j].z + v[j].w); }
        const float mean = wave_sum(s) * (1.f / DMODEL); float s2 = 0.f;
#pragma unroll
        for (int j = 0; j < 4; ++j) { v[j] = v[j] - mean; s2 += (v[j].x * v[j].x + v[j].y * v[j].y) + (v[j].z * v[j].z + v[j].w * v[j].w); }
        const float rstd = 1.f / sqrtf(wave_sum(s2) * (1.f / DMODEL) + LN_EPS);
#pragma unroll
        for (int j = 0; j < 4; ++j) { const f32x4 gg = *(const f32x4*)(a.ln_g + 256 * j + 4 * lane), bb = *(const f32x4*)(a.ln_b + 256 * j + 4 * lane);
            hr[64 * j] = v[j] * rstd * gg + bb; }
    }
}

constexpr int N_PHASES = 9;
#ifndef MK_ONE_LAUNCH
#define MK_ONE_LAUNCH 1
#endif
__global__ void __launch_bounds__(NTHREADS, 2) mk_fwd(Args args) {
    extern __shared__ __attribute__((aligned(16))) unsigned char lds[];
    Frame F;
    F.lds = (LAS unsigned char*)lds;
    F.tid = threadIdx.x; F.lane = F.tid & 63; F.wave = __builtin_amdgcn_readfirstlane(F.tid >> 6);
    F.G = gridDim.x; { const int bx = blockIdx.x; F.vcu = (F.G % 8 == 0) ? (bx % 8) * (F.G / 8) + bx / 8 : bx; }
    unsigned char* ws = args.ws;
    F.w_in_t = (bf16*)(ws + WS_WIN); F.w_out_t = (bf16*)(ws + WS_WOUT); F.xb = (bf16*)(ws + WS_XB); F.proj = (bf16*)(ws + WS_PROJ); F.xc = (bf16*)(ws + WS_XC);
    F.cosT = (float*)(ws + WS_COS); F.sinT = (float*)(ws + WS_SIN); F.dt = (float*)(ws + WS_DT); F.ssq = (float*)(ws + WS_SSQ);
    volatile LAS unsigned* MISC = (volatile LAS unsigned*)(F.lds + MISC_OFF);
    for (int u = F.tid; u < (LDS_BYTES - LDSCTL_OFF) / 4; u += NTHREADS) ((LAS unsigned*)(F.lds + LDSCTL_OFF))[u] = 0u;
    __syncthreads();
    XcdBarrier bar; bar.bar = (unsigned*)(ws + WS_CTL) + CW_BAR; bar.x = 0; bar.st = nullptr;
    if (MK_ONE_LAUNCH) bar = xcd_barrier_post((unsigned*)(ws + WS_CTL) + CW_BAR, MISC + 8);
    const int lo = args.ph_lo, hi = args.ph_hi;
#define IN(k) (lo <= (k) && (k) < hi)
#define SEAM(k) do { if (IN(k) && IN((k) + 1)) xcd_barrier(bar); } while (0)
    if (IN(0)) { p0_prologue(args, F); SEAM(0); }
    if (IN(1)) {
        pg8::Gemm g{F.xb, F.w_in_t, MTOK, LDP, DMODEL, DMODEL, DMODEL}; pg8::StaticOrder S; S.init(MTOK, LDP, F.G, (int)blockIdx.x);
        pg8::EpiBf16 E{F.proj, LDP};
        pg8::gemm_phase<pg8::EpiBf16, pg8::StaticOrder, true, true>(F.lds, g, S, E);
        SEAM(1);
    }
    if (IN(2)) { p_rope(F); SEAM(2); }
    if (IN(3)) { p_conv(args, F); SEAM(3); }
    if (IN(4)) { p_ssd_naive(args, F, args.out); SEAM(4); }
    if (IN(5)) { p_gate_norm(args, F, args.out); SEAM(5); }
    if (IN(6)) { p_attn_naive(args, F); SEAM(6); }
    if (IN(7)) {
        pg8::Gemm g{F.proj, F.w_out_t, MTOK, DMODEL, 2048, LDP, 2048}; pg8::StaticOrder S; S.init(MTOK, DMODEL, F.G, (int)blockIdx.x);
        pg8::EpiF32 E{args.out, DMODEL};
        pg8::gemm_phase<pg8::EpiF32, pg8::StaticOrder, true, true>(F.lds, g, S, E);
        SEAM(7);
    }
    if (IN(8)) { p_ln(args, F); }
#undef IN
#undef SEAM
}

extern "C" void kernel_launch(void* const* d_in, const int* in_sizes, int n_in, void* d_out, int out_size, void* d_ws, size_t ws_size, hipStream_t stream) {
    static int grid = 0;
    if (grid == 0) {
        if (n_in != 13 || in_sizes[0] != MTOK * DMODEL || out_size != MTOK * DMODEL || ws_size < WS_END) {
            fprintf(stderr, "kernel_launch: unexpected shapes (n_in %d, in0 %d, out %d, ws %zu); nothing launched\n", n_in, n_in > 0 ? in_sizes[0] : -1, out_size, ws_size); grid = -1; return; }
        int dev = 0, cus = 0;
        if (hipGetDevice(&dev) != hipSuccess || hipDeviceGetAttribute(&cus, hipDeviceAttributeMultiprocessorCount, dev) != hipSuccess) { grid = -1; return; }
        if (hipFuncSetAttribute((const void*)mk_fwd, hipFuncAttributeMaxDynamicSharedMemorySize, LDS_BYTES) != hipSuccess) { fprintf(stderr, "kernel_launch: hipFuncSetAttribute failed\n"); grid = -1; return; }
        int per_cu = 0;
        if (hipOccupancyMaxActiveBlocksPerMultiprocessor(&per_cu, (const void*)mk_fwd, NTHREADS, LDS_BYTES) != hipSuccess || per_cu < 1) fprintf(stderr, "kernel_launch: occupancy query reports %d\n", per_cu);
        (void)hipGetLastError();
        grid = cus;
    }
    if (grid < 0) return;
    if (hipMemsetAsync((char*)d_ws + WS_CTL, 0, CTL_ZERO_BYTES, stream) != hipSuccess) return;
    Args a{};
    a.x = (const float*)d_in[0]; a.pos = (const int*)d_in[1]; a.w_in = (const float*)d_in[2]; a.conv_w = (const float*)d_in[3]; a.conv_b = (const float*)d_in[4];
    a.dt_bias = (const float*)d_in[5]; a.a_log = (const float*)d_in[6]; a.d_skip = (const float*)d_in[7]; a.norm_w = (const float*)d_in[8]; a.sinks = (const float*)d_in[9];
    a.w_out = (const float*)d_in[10]; a.ln_g = (const float*)d_in[11]; a.ln_b = (const float*)d_in[12];
    a.out = (float*)d_out; a.ws = (unsigned char*)d_ws;
#if MK_ONE_LAUNCH
    a.ph_lo = 0; a.ph_hi = N_PHASES;
    hipLaunchKernelGGL(mk_fwd, dim3(grid), dim3(NTHREADS), LDS_BYTES, stream, a);
#else
    for (int p = 0; p < N_PHASES; ++p) { a.ph_lo = p; a.ph_hi = p + 1; hipLaunchKernelGGL(mk_fwd, dim3(grid), dim3(NTHREADS), LDS_BYTES, stream, a); }
#endif
}
```

```cpp
#include <hip/hip_runtime.h>
#include <cstdio>
#include <cstdint>
#include <cmath>
constexpr int BATCH = 8, SEQ = 4096, DMODEL = 1024, MTOK = BATCH * SEQ;
constexpr int NH = 16, HD = 64, NST = 128, DXBC = 1536;
constexpr int DIN = 5136, OFF_XBC = 1024, OFF_DT = 2560, OFF_Q = 2576, OFF_K = 3600, OFF_V = 3856, OFF_G = 4112;
constexpr int LDP = 5120, PC_Z = 0, PC_Q = 1024, PC_XBC = 2048, PC_K = 3584, PC_V = 3840, PC_G = 4096;
constexpr float ALPHA = 1.189207115002721f, LN_EPS = 1e-5f, RMS_EPS = 1e-5f;
constexpr float LOG2E = 1.4426950408889634f, C2 = 0.125f * LOG2E;

constexpr size_t MiB = 1u << 20;
constexpr size_t WS_CTL = 0, CTL_ZERO_BYTES = 1 * MiB;
constexpr size_t WS_WIN = 1 * MiB;
constexpr size_t WS_WOUT = 11 * MiB;
constexpr size_t WS_COS = 15 * MiB, WS_SIN = 16 * MiB;
constexpr size_t WS_DT = 17 * MiB;
constexpr size_t WS_SSQ = 19 * MiB;
constexpr size_t WS_XB = 24 * MiB;
constexpr size_t WS_PROJ = 88 * MiB;
constexpr size_t WS_XC = 408 * MiB;
constexpr size_t WS_END = 504 * MiB;

constexpr int CW_TMO = 0, CW_CODE = 1, CW_BAR = 4096;

constexpr int NWAVES = 8, NTHREADS = 512;
constexpr int RING_BYTES = 143360, LDSCTL_OFF = RING_BYTES, MISC_OFF = LDSCTL_OFF + 320, LDS_BYTES = 147456;

#define GAS __attribute__((address_space(1)))
#define LAS __attribute__((address_space(3)))
typedef unsigned short bf16;
typedef unsigned v4u __attribute__((ext_vector_type(4)));
typedef unsigned v2u __attribute__((ext_vector_type(2)));
typedef float f32x4 __attribute__((ext_vector_type(4)));
typedef GAS unsigned gu32;
#define RLX_AGENT __ATOMIC_RELAXED, __HIP_MEMORY_SCOPE_AGENT
#define LDS_WAIT() asm volatile("s_waitcnt lgkmcnt(0)" ::: "memory")
#define VM_WAIT() asm volatile("s_waitcnt vmcnt(0)" ::: "memory")
__device__ __forceinline__ unsigned f2bf(float f) { unsigned u = __builtin_bit_cast(unsigned, f); return (u + 0x7fffu + ((u >> 16) & 1u)) >> 16; }
__device__ __forceinline__ unsigned pk2(float lo, float hi) { return f2bf(lo) | (f2bf(hi) << 16); }
__device__ __forceinline__ float bf2f(unsigned u16) { return __builtin_bit_cast(float, u16 << 16); }
__device__ __forceinline__ float bflo(unsigned w) { return __builtin_bit_cast(float, w << 16); }
__device__ __forceinline__ float bfhi(unsigned w) { return __builtin_bit_cast(float, w & 0xffff0000u); }
__device__ __forceinline__ float wave_sum(float v) {
#pragma unroll
    for (int o = 1; o < 64; o <<= 1) v += __shfl_xor(v, o);
    return v;
}
__device__ __forceinline__ float silu_f(float v) { return v * __builtin_amdgcn_rcpf(1.f + __expf(-v)); }

namespace pg8 {
#define PG8_LAS __attribute__((address_space(3)))
typedef unsigned short bf16_t;
typedef short bf16x8 __attribute__((ext_vector_type(8)));
typedef float f32x4 __attribute__((ext_vector_type(4)));
typedef unsigned u32x4 __attribute__((ext_vector_type(4)));
constexpr int BM = 256, BK = 64, HALF = 128, HTB = HALF * BK * 2  , STAGE_BYTES = 8 * HTB, NXCD = 8, WGM = 8;

__host__ __device__ __forceinline__ int lds_byte(int r, int c) { const int st = (r >> 4) * 2 + (c >> 5), rr = r & 15, cc = c & 31, ob = rr * 64 + cc * 2; return st * 1024 + (ob ^ (((ob >> 9) & 1) << 5)); }
__host__ __device__ __forceinline__ void stage_rc(int b, int& R, int& C) { const int st = b / 1024, sb = b % 1024, swz = sb ^ (((sb >> 9) & 1) << 5); R = (st >> 1) * 16 + swz / 64; C = (st & 1) * 32 + (swz % 64) / 2; }
__host__ __device__ __forceinline__ int perm32(int rho) { const int n = rho >> 4, i = rho & 15; return 8 * (i >> 2) + 4 * n + (i & 3); }

struct Unit { int pm, pn; };
struct Gemm { const bf16_t* A; const bf16_t* Bt; int M, N, K, lda, ldb; };

struct StaticOrder {
    int nM, nN, nwg, G, c;
    __host__ __device__ void init(int M, int N, int G_, int c_) { nM = M / BM; nN = N / BM; nwg = nM * nN; G = G_; c = c_; }
    __host__ __device__ bool next(int i, Unit& u) const {
        const long L = (long)i * G + c; if (L >= nwg) return false;
        int wgid = (int)L; { const int q = nwg / NXCD, r = nwg % NXCD, xcd = wgid % NXCD, off = wgid / NXCD; wgid = (xcd < r ? xcd * (q + 1) : r * (q + 1) + (xcd - r) * q) + off; }
        const int nig = WGM * nN, gid = wgid / nig, fm = gid * WGM, gsz = (nM - fm) < WGM ? (nM - fm) : WGM;
        u.pm = fm + ((wgid % nig) % gsz); u.pn = (wgid % nig) / gsz; return true;
    }
};
struct OneUnitOrder {
    StaticOrder so; int rnd;
    __host__ __device__ bool next(int i, Unit& u) const { if (i != 0) return false; return so.next(rnd, u); }
};

__device__ __forceinline__ unsigned cvt_pk_bf16(float lo, float hi) { unsigned r; asm volatile("v_cvt_pk_bf16_f32 %0, %1, %2" : "=v"(r) : "v"(lo), "v"(hi)); return r; }
struct EpiBf16 {
    static constexpr bool PERM = true, AFTER_DRAIN = false;
    bf16_t* O; int ldc;
    __device__ __forceinline__ void operator()(const f32x4 (&acc)[2][2][4][2], const Unit& u, int wr, int wc, int fr, int fq) const {
        const int row0 = u.pm * BM + wr * 64 + fr; const int col0 = u.pn * BM + wc * 32 + 8 * fq;
#pragma unroll
        for (int ai = 0; ai < 2; ++ai)
#pragma unroll
            for (int m = 0; m < 4; ++m) { bf16_t* rowp = O + (size_t)(row0 + ai * HALF + m * 16) * ldc + col0;
#pragma unroll
                for (int bj = 0; bj < 2; ++bj) { const f32x4 v0 = acc[ai][bj][m][0], v1 = acc[ai][bj][m][1];
                    u32x4 w; w.x = cvt_pk_bf16(v0[0], v0[1]); w.y = cvt_pk_bf16(v0[2], v0[3]); w.z = cvt_pk_bf16(v1[0], v1[1]); w.w = cvt_pk_bf16(v1[2], v1[3]);
                    *(u32x4*)(rowp + bj * HALF) = w; } }
    }
};
struct EpiF32 {
    static constexpr bool PERM = false, AFTER_DRAIN = false;
    float* O; int ldc;
    __device__ __forceinline__ void operator()(const f32x4 (&acc)[2][2][4][2], const Unit& u, int wr, int wc, int fr, int fq) const {
        const int col0 = u.pn * BM + wc * 32 + 4 * fq;
#pragma unroll
        for (int ai = 0; ai < 2; ++ai)
#pragma unroll
            for (int m = 0; m < 4; ++m) { const int r = ai * HALF + wr * 64 + m * 16 + fr; float* rowp = O + (size_t)(u.pm * BM + r) * ldc + col0;
#pragma unroll
                for (int bj = 0; bj < 2; ++bj)
#pragma unroll
                    for (int n = 0; n < 2; ++n) *(f32x4*)(rowp + bj * HALF + n * 16) = acc[ai][bj][m][n]; }
    }
};
struct EpiProj {
    static constexpr bool PERM = true, AFTER_DRAIN = false;
    bf16_t* O; int ldc; const float* cosT; const float* sinT;
    __device__ __forceinline__ void operator()(const f32x4 (&acc)[2][2][4][2], const Unit& u, int wr, int wc, int fr, int fq) const {
        const int row0 = u.pm * BM + wr * 64 + fr; const int col0 = u.pn * BM + wc * 32 + 8 * fq;
        const int pn = u.pn;
        const bool is_silu = pn < 4 || pn >= 16;
        const bool is_rope = ((pn >= 4 && pn < 8) || pn == 14) && ((wc & 1) == 0);
        const float sgn = fq == 0 ? -1.f : (fq == 1 ? 1.f : 0.f);
#pragma unroll
        for (int ai = 0; ai < 2; ++ai)
#pragma unroll
            for (int m = 0; m < 4; ++m) { const int row = row0 + ai * HALF + m * 16; bf16_t* rowp = O + (size_t)row * ldc + col0;
                f32x4 c0 = (f32x4){1.f, 1.f, 1.f, 1.f}, c1 = c0, s0 = (f32x4){0.f, 0.f, 0.f, 0.f}, s1 = s0;
                if (is_rope) { c0 = *(const f32x4*)(cosT + (size_t)row * 8); c1 = *(const f32x4*)(cosT + (size_t)row * 8 + 4); s0 = *(const f32x4*)(sinT + (size_t)row * 8); s1 = *(const f32x4*)(sinT + (size_t)row * 8 + 4);
                    if (fq >= 2) { c0 = (f32x4){1.f, 1.f, 1.f, 1.f}; c1 = c0; } s0 = s0 * sgn; s1 = s1 * sgn; }
#pragma unroll
                for (int bj = 0; bj < 2; ++bj) { f32x4 v0 = acc[ai][bj][m][0], v1 = acc[ai][bj][m][1];
                    if (is_silu) {
#pragma unroll
                        for (int e = 0; e < 4; ++e) { v0[e] = v0[e] * __builtin_amdgcn_rcpf(1.f + __expf(-v0[e])); v1[e] = v1[e] * __builtin_amdgcn_rcpf(1.f + __expf(-v1[e])); }
                    } else if (is_rope) {
                        f32x4 p0, p1;
#pragma unroll
                        for (int e = 0; e < 4; ++e) { p0[e] = __shfl_xor(v0[e], 16); p1[e] = __shfl_xor(v1[e], 16); }
                        v0 = v0 * c0 + p0 * s0; v1 = v1 * c1 + p1 * s1;
                    }
                    u32x4 w; w.x = cvt_pk_bf16(v0[0], v0[1]); w.y = cvt_pk_bf16(v0[2], v0[3]); w.z = cvt_pk_bf16(v1[0], v1[1]); w.w = cvt_pk_bf16(v1[2], v1[3]);
                    *(u32x4*)(rowp + bj * HALF) = w; } }
    }
};
template <class Epi, class Sched, bool ALIGN_EPI = false, bool SP2 = false>
__device__ __forceinline__ void gemm_phase(PG8_LAS unsigned char* lds, const Gemm g, const Sched& S, const Epi& E) {
    const int tid = threadIdx.x, wid = __builtin_amdgcn_readfirstlane(tid >> 6), lane = tid & 63, wr = wid >> 2, wc = wid & 3, fr = lane & 15, fq = lane >> 4;
    const int K = g.K, nt = K / BK;
    unsigned voffA[2], voffB[2];
#pragma unroll
    for (int i = 0; i < 2; ++i) { int R, C; stage_rc(tid * 16 + i * 8192, R, C); const int Rb = Epi::PERM ? ((R & ~31) + perm32(R & 31)) : R;
        voffA[i] = (unsigned)(R * g.lda + C) * 2u; voffB[i] = (unsigned)(Rb * g.ldb + C) * 2u; }
    const size_t kstep = (size_t)(BK * 2);
    const size_t hstepA = (size_t)HALF * g.lda * 2, hstepB = (size_t)HALF * g.ldb * 2;
    const size_t tstepA = 2 * hstepA, tstepB = 2 * hstepB;
    const unsigned ldsw = (unsigned)wid * 1024u;
    const int aoff = lds_byte(wr * 64 + fr, fq * 8), boff = lds_byte(wc * 32 + fr, fq * 8);
#define PG8_SA(b, h) (((b) * 2 + (h)) * HTB)
#define PG8_SB(b, h) ((4 + (b) * 2 + (h)) * HTB)
#define PG8_STAGE(bufoff, gbase, voff) do { _Pragma("unroll") for (int _i = 0; _i < 2; ++_i) \
        __builtin_amdgcn_global_load_lds((const unsigned*)((const char*)(gbase) + (voff)[_i]), (PG8_LAS unsigned*)(lds + (bufoff) + ldsw + _i * 8192), 16, 0, 0); } while (0)
#define PG8_LDA(dst, b, h) do { _Pragma("unroll") for (int m = 0; m < 4; ++m) _Pragma("unroll") for (int k = 0; k < 2; ++k) dst[m][k] = *(const PG8_LAS bf16x8*)(lds + PG8_SA(b, h) + aoff + m * 2048 + k * 1024); } while (0)
#define PG8_LDB(dst, b, h) do { _Pragma("unroll") for (int n = 0; n < 2; ++n) _Pragma("unroll") for (int k = 0; k < 2; ++k) dst[n][k] = *(const PG8_LAS bf16x8*)(lds + PG8_SB(b, h) + boff + n * 2048 + k * 1024); } while (0)
#define PG8_MMA(ai, bj, At, Bt) do { __builtin_amdgcn_s_setprio(1); _Pragma("unroll") for (int m = 0; m < 4; ++m) _Pragma("unroll") for (int n = 0; n < 2; ++n) _Pragma("unroll") for (int k = 0; k < 2; ++k) \
        acc[ai][bj][m][n] = __builtin_amdgcn_mfma_f32_16x16x32_bf16(Bt[n][k], At[m][k], acc[ai][bj][m][n], 0, 0, 0); __builtin_amdgcn_s_setprio(0); } while (0)
#define PG8_WAIT_V(n) asm volatile("s_waitcnt vmcnt(" #n ")" ::: "memory")
#define PG8_WAIT_L(n) asm volatile("s_waitcnt lgkmcnt(" #n ")" ::: "memory")
#define PG8_BAR __builtin_amdgcn_s_barrier()
#define PG8_SCHED __builtin_amdgcn_sched_barrier(0)
    Unit cur, nxt; int ui = 0;
    if (!S.next(0, cur)) return;
    f32x4 acc[2][2][4][2];
#pragma unroll
    for (int a = 0; a < 2; ++a)
#pragma unroll
        for (int b = 0; b < 2; ++b)
#pragma unroll
            for (int m = 0; m < 4; ++m)
#pragma unroll
                for (int n = 0; n < 2; ++n) acc[a][b][m][n] = (f32x4){0.f, 0.f, 0.f, 0.f};
    bf16x8 At[4][2], B0[2][2], B1[2][2];
    const char* cA = (const char*)g.A + (size_t)cur.pm * tstepA; const char* cB = (const char*)g.Bt + (size_t)cur.pn * tstepB;
    if constexpr (SP2) {
        PG8_STAGE(PG8_SB(0, 0), cB, voffB); PG8_STAGE(PG8_SB(0, 1), cB + hstepB, voffB); PG8_STAGE(PG8_SA(0, 0), cA, voffA); PG8_STAGE(PG8_SA(0, 1), cA + hstepA, voffA);
        if (wr == 1) PG8_BAR;
        PG8_WAIT_V(2); PG8_BAR;
        PG8_STAGE(PG8_SB(1, 0), cB + kstep, voffB); PG8_STAGE(PG8_SA(1, 0), cA + kstep, voffA); PG8_STAGE(PG8_SB(1, 1), cB + hstepB + kstep, voffB);
        PG8_WAIT_V(6); PG8_BAR;
    } else {
        PG8_STAGE(PG8_SB(0, 0), cB, voffB); PG8_STAGE(PG8_SA(0, 0), cA, voffA); PG8_STAGE(PG8_SB(0, 1), cB + hstepB, voffB); PG8_STAGE(PG8_SA(0, 1), cA + hstepA, voffA);
        if (wr == 1) PG8_BAR;
        PG8_WAIT_V(4); PG8_BAR;
        PG8_STAGE(PG8_SB(1, 0), cB + kstep, voffB); PG8_STAGE(PG8_SA(1, 0), cA + kstep, voffA); PG8_STAGE(PG8_SB(1, 1), cB + hstepB + kstep, voffB);
        PG8_WAIT_V(6); PG8_BAR;
    }
    for (;;) {
        const bool has_next = S.next(ui + 1, nxt);
        const char* nA = has_next ? (const char*)g.A + (size_t)nxt.pm * tstepA : cA; const char* nB = has_next ? (const char*)g.Bt + (size_t)nxt.pn * tstepB : cB;
        for (int t = 0; t < nt; t += 2) {
            const bool last = (t == nt - 2);
            const char* a1 = cA + (size_t)(t + 1) * kstep;
            const char* a2 = last ? nA : cA + (size_t)(t + 2) * kstep; const char* b2 = last ? nB : cB + (size_t)(t + 2) * kstep;
            const char* a3 = a2 + kstep; const char* b3 = b2 + kstep;
            if constexpr (SP2) {
            PG8_LDB(B0, 0, 0); PG8_LDB(B1, 0, 1); PG8_SCHED; PG8_LDA(At, 0, 0); PG8_STAGE(PG8_SA(1, 1), a1 + hstepA, voffA);
            PG8_WAIT_V(8); PG8_WAIT_L(0); PG8_BAR; PG8_MMA(0, 0, At, B0); PG8_MMA(0, 1, At, B1); PG8_BAR; PG8_SCHED;
            PG8_LDA(At, 0, 1); PG8_STAGE(PG8_SB(0, 0), b2, voffB); PG8_STAGE(PG8_SB(0, 1), b2 + hstepB, voffB); PG8_STAGE(PG8_SA(0, 0), a2, voffA);
            PG8_WAIT_V(8); PG8_WAIT_L(0); PG8_BAR; PG8_MMA(1, 0, At, B0); PG8_MMA(1, 1, At, B1); PG8_BAR; PG8_SCHED;
            PG8_LDB(B0, 1, 0); PG8_LDB(B1, 1, 1); PG8_SCHED; PG8_LDA(At, 1, 0); PG8_STAGE(PG8_SA(0, 1), a2 + hstepA, voffA);
            PG8_WAIT_V(8); PG8_WAIT_L(0); PG8_BAR; PG8_MMA(0, 0, At, B0); PG8_MMA(0, 1, At, B1); PG8_BAR; PG8_SCHED;
            PG8_LDA(At, 1, 1); PG8_STAGE(PG8_SB(1, 0), b3, voffB); PG8_STAGE(PG8_SB(1, 1), b3 + hstepB, voffB); PG8_STAGE(PG8_SA(1, 0), a3, voffA);
            PG8_WAIT_V(8); PG8_WAIT_L(0); PG8_BAR; PG8_MMA(1, 0, At, B0); PG8_MMA(1, 1, At, B1); PG8_BAR; PG8_SCHED;
            } else {
            PG8_LDB(B0, 0, 0); PG8_SCHED; PG8_LDA(At, 0, 0); PG8_STAGE(PG8_SA(1, 1), a1 + hstepA, voffA);
            PG8_WAIT_L(8); PG8_BAR; PG8_WAIT_L(0); PG8_MMA(0, 0, At, B0); PG8_BAR; PG8_SCHED;
            PG8_LDB(B1, 0, 1); PG8_STAGE(PG8_SB(0, 0), b2, voffB);
            PG8_BAR; PG8_WAIT_L(0); PG8_MMA(0, 1, At, B1); PG8_BAR;
            PG8_LDA(At, 0, 1); PG8_STAGE(PG8_SA(0, 0), a2, voffA);
            PG8_BAR; PG8_WAIT_L(0); PG8_MMA(1, 0, At, B0); PG8_BAR; PG8_SCHED;
            PG8_STAGE(PG8_SB(0, 1), b2 + hstepB, voffB);
            PG8_WAIT_V(6); PG8_BAR; PG8_MMA(1, 1, At, B1); PG8_BAR;
            PG8_LDB(B0, 1, 0); PG8_SCHED; PG8_LDA(At, 1, 0); PG8_STAGE(PG8_SA(0, 1), a2 + hstepA, voffA);
            PG8_WAIT_L(8); PG8_BAR; PG8_WAIT_L(0); PG8_MMA(0, 0, At, B0); PG8_BAR; PG8_SCHED;
            PG8_LDB(B1, 1, 1); PG8_STAGE(PG8_SB(1, 0), b3, voffB);
            PG8_BAR; PG8_WAIT_L(0); PG8_MMA(0, 1, At, B1); PG8_BAR;
            PG8_LDA(At, 1, 1); PG8_STAGE(PG8_SA(1, 0), a3, voffA);
            PG8_BAR; PG8_WAIT_L(0); PG8_MMA(1, 0, At, B0); PG8_BAR; PG8_SCHED;
            PG8_STAGE(PG8_SB(1, 1), b3 + hstepB, voffB);
            PG8_WAIT_V(6); PG8_BAR; PG8_MMA(1, 1, At, B1); PG8_BAR;
            }
        }
        if constexpr (ALIGN_EPI) { if (wr == 0) PG8_BAR; }
        if constexpr (!Epi::AFTER_DRAIN) { E(acc, cur, wr, wc, fr, fq); }
        if (!has_next) break;
#pragma unroll
        for (int a = 0; a < 2; ++a)
#pragma unroll
            for (int b = 0; b < 2; ++b)
#pragma unroll
                for (int m = 0; m < 4; ++m)
#pragma unroll
                    for (int n = 0; n < 2; ++n) acc[a][b][m][n] = (f32x4){0.f, 0.f, 0.f, 0.f};
        cur = nxt; cA = nA; cB = nB; ++ui;
        if constexpr (ALIGN_EPI) { if (wr == 1) PG8_BAR; }
    }
    PG8_WAIT_V(0);
    if constexpr (!ALIGN_EPI) { if (wr == 0) PG8_BAR; }
    PG8_BAR;
    if constexpr (Epi::AFTER_DRAIN) { E.fused(acc, cur, wr, wc, fr, fq, lds, wid, lane); }
#undef PG8_SA
#undef PG8_SB
#undef PG8_STAGE
#undef PG8_LDA
#undef PG8_LDB
#undef PG8_MMA
#undef PG8_WAIT_V
#undef PG8_WAIT_L
#undef PG8_BAR
#undef PG8_SCHED
}
}
namespace att {
typedef __attribute__((ext_vector_type(8))) short bf16x8;
typedef __attribute__((ext_vector_type(4))) short s16x4;
typedef __attribute__((ext_vector_type(16))) float f32x16;
typedef __attribute__((ext_vector_type(4))) unsigned u32x4;
typedef short v4i16_t __attribute__((ext_vector_type(4)));
typedef float f32x2_t __attribute__((ext_vector_type(2))); typedef __bf16 bf16x2_t __attribute__((ext_vector_type(2)));
typedef __attribute__((address_space(3))) const char* lds_cptr;
typedef __attribute__((address_space(3))) char* lds_ptr;
constexpr int BLKB = 32768, KTB = 8192;
#define SBAR() __builtin_amdgcn_sched_barrier(0)
constexpr int L_SCR = 3 * BLKB, L_OST = L_SCR + 8 * 256, L_END = L_OST + 8 * 4096;
__device__ __forceinline__ int crow(int r, int hi) { return (r & 3) + 8 * (r >> 2) + 4 * hi; }
__device__ __forceinline__ void glds16(const void* gsrc, unsigned lds_dst) { unsigned keep;
    asm volatile("s_mov_b32 %0, m0\n\ts_mov_b32 m0, %2\n\ts_nop 0\n\tglobal_load_lds_dwordx4 %1, off\n\ts_mov_b32 m0, %0" : "=&s"(keep) : "v"(gsrc), "s"(lds_dst) : "memory"); }
__device__ __forceinline__ unsigned cvtpk(float lo, float hi) { f32x2_t v = {lo, hi}; bf16x2_t b = __builtin_convertvector(v, bf16x2_t); return __builtin_bit_cast(unsigned, b); }
__device__ __forceinline__ s16x4 vtr(lds_cptr p) { return __builtin_bit_cast(s16x4, __builtin_amdgcn_ds_read_tr16_b64_v4i16((__attribute__((address_space(3))) v4i16_t*)p)); }
__device__ __forceinline__ float swapmax(float m) { auto rr = __builtin_amdgcn_permlane32_swap(__float_as_uint(m), __float_as_uint(m), false, false); return fmaxf(__uint_as_float(rr[0]), __uint_as_float(rr[1])); }
__device__ __forceinline__ float swapadd(float m) { auto rr = __builtin_amdgcn_permlane32_swap(__float_as_uint(m), __float_as_uint(m), false, false); return __uint_as_float(rr[0]) + __uint_as_float(rr[1]); }

__device__ __forceinline__ void dma_block(const unsigned short* proj, size_t row0, int kvh, unsigned slot, int wid, int lane) {
    const unsigned short* kb = proj + row0 * LDP + PC_K + kvh * 64 + (size_t)lane * LDP + wid * 8;
    const unsigned short* vb = proj + row0 * LDP + PC_V + kvh * 64 + (size_t)(16 * (wid & 3) + (lane >> 2)) * LDP + (wid >> 2) * 32 + (lane & 3) * 8;
    const unsigned d = (unsigned)__builtin_amdgcn_readfirstlane((int)(slot + wid * 1024));
    glds16(kb, d); glds16(kb + (size_t)64 * LDP, d + KTB); glds16(vb, d + 2 * KTB); glds16(vb + (size_t)64 * LDP, d + 3 * KTB);
}
__device__ __forceinline__ void qkt(f32x16& p0, f32x16& p1, lds_cptr kt, const bf16x8* qr, int r32, int hi) {
    lds_cptr kb = kt + hi * 1024 + r32 * 16;
    const f32x16 z = {};
#pragma unroll
    for (int d0 = 0; d0 < 4; ++d0) {
        const bf16x8 b0 = *(const __attribute__((address_space(3))) bf16x8*)(kb + d0 * 2048);
        const bf16x8 b1 = *(const __attribute__((address_space(3))) bf16x8*)(kb + d0 * 2048 + 512);
        if (d0 == 0) { p0 = __builtin_amdgcn_mfma_f32_32x32x16_bf16(b0, qr[0], z, 0, 0, 0); p1 = __builtin_amdgcn_mfma_f32_32x32x16_bf16(b1, qr[0], z, 0, 0, 0); }
        else { p0 = __builtin_amdgcn_mfma_f32_32x32x16_bf16(b0, qr[d0], p0, 0, 0, 0); p1 = __builtin_amdgcn_mfma_f32_32x32x16_bf16(b1, qr[d0], p1, 0, 0, 0); } }
}
__device__ __forceinline__ void pv(f32x16* o, int vb, const u32x4* pw) {
#pragma unroll
    for (int d0 = 0; d0 < 2; ++d0) { s16x4 lo[4], hh[4];
#pragma unroll
        for (int ks = 0; ks < 4; ++ks) {
            asm volatile("ds_read_b64_tr_b16 %0,%1 offset:%c2" : "=&v"(lo[ks]) : "v"(vb), "i"(d0 * 4096 + ks * 1024) : "memory");
            asm volatile("ds_read_b64_tr_b16 %0,%1 offset:%c2" : "=&v"(hh[ks]) : "v"(vb), "i"(d0 * 4096 + ks * 1024 + 512) : "memory"); }
        asm volatile("s_waitcnt lgkmcnt(0)" ::: "memory"); SBAR();
#pragma unroll
        for (int ks = 0; ks < 4; ++ks) { const bf16x8 vf = (bf16x8){lo[ks][0], lo[ks][1], lo[ks][2], lo[ks][3], hh[ks][0], hh[ks][1], hh[ks][2], hh[ks][3]};
            o[d0] = __builtin_amdgcn_mfma_f32_32x32x16_bf16(__builtin_bit_cast(bf16x8, pw[ks]), vf, o[d0], 0, 0, 0); }
    }
}
__device__ __forceinline__ void pack_tile(u32x4* pw, const f32x16& p0, const f32x16& p1) {
    pw[0] = (u32x4){cvtpk(p0[0], p0[1]), cvtpk(p0[2], p0[3]), cvtpk(p0[4], p0[5]), cvtpk(p0[6], p0[7])};
    pw[1] = (u32x4){cvtpk(p0[8], p0[9]), cvtpk(p0[10], p0[11]), cvtpk(p0[12], p0[13]), cvtpk(p0[14], p0[15])};
    pw[2] = (u32x4){cvtpk(p1[0], p1[1]), cvtpk(p1[2], p1[3]), cvtpk(p1[4], p1[5]), cvtpk(p1[6], p1[7])};
    pw[3] = (u32x4){cvtpk(p1[8], p1[9]), cvtpk(p1[10], p1[11]), cvtpk(p1[12], p1[13]), cvtpk(p1[14], p1[15])};
}
__device__ __forceinline__ void group32(const bf16x8* qr, lds_cptr k0, lds_cptr k1, lds_cptr k2, int v0, int v1, int v2, bool dead0, bool dead1, int qrel0, float sink2,
                                        unsigned short* qout, const unsigned short* gin, lds_ptr wsf_b, lds_ptr stg_b, int lane) {
    const int r32 = lane & 31, hi = lane >> 5; int qrel = qrel0 + r32; asm volatile("" : "+v"(qrel));
    const int vlane = ((lane >> 4) & 1) * 32 + (lane & 3) * 8 + (4 * hi + ((lane & 15) >> 2)) * 64;
    const float NEG = -INFINITY;
    f32x16 a0, a1, b0, b1, c0, c1;
    SBAR(); qkt(a0, a1, k0, qr, r32, hi); SBAR(); qkt(b0, b1, k1, qr, r32, hi); SBAR(); qkt(c0, c1, k2, qr, r32, hi); SBAR();
#pragma unroll
    for (int r = 0; r < 16; ++r) { const int kv = crow(r, hi);
        if (dead0 || !(kv > qrel)) a0[r] = NEG; if (dead0 || !(kv + 32 > qrel)) a1[r] = NEG;
        if (dead1) { b0[r] = NEG; b1[r] = NEG; }
        if (!(kv <= qrel)) c0[r] = NEG; if (!(kv + 32 <= qrel)) c1[r] = NEG; }
    SBAR();
    float mx = sink2;
#pragma unroll
    for (int r = 0; r < 16; ++r) { mx = fmaxf(mx, fmaxf(fmaxf(a0[r], a1[r]), fmaxf(fmaxf(b0[r], b1[r]), fmaxf(c0[r], c1[r])))); }
    mx = swapmax(mx);
    float rs = 0.f;
#pragma unroll
    for (int r = 0; r < 16; ++r) { a0[r] = __builtin_amdgcn_exp2f(a0[r] - mx); a1[r] = __builtin_amdgcn_exp2f(a1[r] - mx); b0[r] = __builtin_amdgcn_exp2f(b0[r] - mx); b1[r] = __builtin_amdgcn_exp2f(b1[r] - mx);
        c0[r] = __builtin_amdgcn_exp2f(c0[r] - mx); c1[r] = __builtin_amdgcn_exp2f(c1[r] - mx); rs += (a0[r] + a1[r]) + (b0[r] + b1[r]) + (c0[r] + c1[r]); }
    SBAR();
    const float l = swapadd(rs) + __builtin_amdgcn_exp2f(sink2 - mx);
    f32x16 o[2]; o[0] = f32x16{}; o[1] = f32x16{};
    u32x4 pw[4];
    SBAR(); pack_tile(pw, a0, a1); pv(o, v0 + vlane, pw);
    SBAR(); pack_tile(pw, b0, b1); pv(o, v1 + vlane, pw);
    SBAR(); pack_tile(pw, c0, c1); pv(o, v2 + vlane, pw); SBAR();
    __attribute__((address_space(3))) float* wsf = (__attribute__((address_space(3))) float*)wsf_b;
    if (hi == 0) wsf[r32] = __builtin_amdgcn_rcpf(l);
    asm volatile("s_waitcnt lgkmcnt(0)" ::: "memory");
    __attribute__((address_space(3))) unsigned short* stg = (__attribute__((address_space(3))) unsigned short*)stg_b;
    __attribute__((address_space(3))) float* wsfl = wsf + 4 * hi; asm volatile("" : "+v"(wsfl));
    __attribute__((address_space(3))) unsigned short* stgl = stg + 4 * hi * 64 + r32; asm volatile("" : "+v"(stgl));
#pragma unroll
    for (int r = 0; r < 16; ++r) { const int ro = (r & 3) + 8 * (r >> 2); const float rl = wsfl[ro];
        stgl[ro * 64] = (unsigned short)(cvtpk(o[0][r] * rl, 0.f) & 0xffffu); stgl[ro * 64 + 32] = (unsigned short)(cvtpk(o[1][r] * rl, 0.f) & 0xffffu); }
    asm volatile("s_waitcnt lgkmcnt(0)" ::: "memory");
#pragma unroll
    for (int i = 0; i < 4; ++i) { const int row = i * 8 + (lane >> 3), ch = lane & 7;
        const u32x4 ov = *(const __attribute__((address_space(3))) u32x4*)(stg + row * 64 + ch * 8);
        const u32x4 gv = *(const u32x4*)(gin + (size_t)row * LDP + ch * 8);
        u32x4 w;
        w.x = cvtpk(__uint_as_float(ov.x << 16) * __uint_as_float(gv.x << 16), __uint_as_float(ov.x & 0xffff0000u) * __uint_as_float(gv.x & 0xffff0000u));
        w.y = cvtpk(__uint_as_float(ov.y << 16) * __uint_as_float(gv.y << 16), __uint_as_float(ov.y & 0xffff0000u) * __uint_as_float(gv.y & 0xffff0000u));
        w.z = cvtpk(__uint_as_float(ov.z << 16) * __uint_as_float(gv.z << 16), __uint_as_float(ov.z & 0xffff0000u) * __uint_as_float(gv.z & 0xffff0000u));
        w.w = cvtpk(__uint_as_float(ov.w << 16) * __uint_as_float(gv.w << 16), __uint_as_float(ov.w & 0xffff0000u) * __uint_as_float(gv.w & 0xffff0000u));
        *(u32x4*)(qout + (size_t)row * LDP + ch * 8) = w; }
    asm volatile("s_waitcnt lgkmcnt(0)" ::: "memory");
}
__device__ __forceinline__ void attn_run(unsigned short* proj, const float* sinks, int b, int kvh, int nb0, int cnt, lds_ptr shm, unsigned lds0) {
    const int tid = threadIdx.x, lane = tid & 63, r32 = lane & 31, hi = lane >> 5; const int wid = __builtin_amdgcn_readfirstlane(tid >> 6);
    const int hq = kvh * 4 + (wid >> 1), th = wid & 1;
    const float sink2 = sinks[hq] * LOG2E;
    const size_t rowb = (size_t)b * SEQ;
    asm volatile("s_waitcnt vmcnt(0) lgkmcnt(0)\n\ts_barrier" ::: "memory");
    if (nb0 > 0) dma_block(proj, rowb + (size_t)(nb0 - 1) * 128, kvh, lds0 + ((nb0 + 2) % 3) * BLKB, wid, lane);
    else { __attribute__((address_space(3))) u32x4* z = (__attribute__((address_space(3))) u32x4*)(shm + 2 * BLKB);
#pragma unroll
        for (int i = 0; i < 4; ++i) z[tid + 512 * i] = (u32x4){0u, 0u, 0u, 0u}; }
    dma_block(proj, rowb + (size_t)nb0 * 128, kvh, lds0 + (nb0 % 3) * BLKB, wid, lane);
    for (int nb = nb0; nb < nb0 + cnt; ++nb) {
        const int sprev = (nb + 2) % 3, scur = nb % 3, snext = (nb + 1) % 3;
        const size_t row0 = rowb + (size_t)nb * 128 + 64 * th;
        unsigned short* qbase = proj + row0 * LDP + PC_Q + hq * 64;
        const unsigned short* gbase = proj + row0 * LDP + PC_G + hq * 64;
        bf16x8 qa[4], qb[4];
#pragma unroll
        for (int d0 = 0; d0 < 4; ++d0) { qa[d0] = *(const bf16x8*)(qbase + (size_t)r32 * LDP + d0 * 16 + hi * 8); qb[d0] = *(const bf16x8*)(qbase + (size_t)(32 + r32) * LDP + d0 * 16 + hi * 8); }
        asm volatile("" : "+v"(qa[0]), "+v"(qa[1]), "+v"(qa[2]), "+v"(qa[3]), "+v"(qb[0]), "+v"(qb[1]), "+v"(qb[2]), "+v"(qb[3]));
        asm volatile("s_waitcnt vmcnt(0) lgkmcnt(0)\n\ts_barrier" ::: "memory");
        if (nb + 1 < nb0 + cnt) dma_block(proj, rowb + (size_t)(nb + 1) * 128, kvh, lds0 + snext * BLKB, wid, lane);
        lds_cptr P = (lds_cptr)shm + sprev * BLKB, C = (lds_cptr)shm + scur * BLKB;
        lds_cptr k0 = th ? P + KTB : P, k1 = th ? C : P + KTB, k2 = th ? C + KTB : C;
        const int vP = (int)lds0 + sprev * BLKB + 2 * KTB, vC = (int)lds0 + scur * BLKB + 2 * KTB;
        const int v0 = th ? vP + KTB : vP, v1 = th ? vC : vP + KTB, v2 = th ? vC + KTB : vC;
        const bool noprev = (nb == 0);
        const bool dead0 = noprev, dead1 = noprev && (th == 0);
        group32(qa, k0, k1, k2, v0, v1, v2, dead0, dead1, 0, sink2, qbase, gbase, shm + L_SCR + wid * 256, shm + L_OST + wid * 4096, lane);
        __builtin_amdgcn_sched_barrier(0);
        group32(qb, k0, k1, k2, v0, v1, v2, dead0, dead1, 32, sink2, qbase + (size_t)32 * LDP, gbase + (size_t)32 * LDP, shm + L_SCR + wid * 256, shm + L_OST + wid * 4096, lane);
    }
}
#undef SBAR
}
#define XB_TMO      128
#define XB_XCNT(j)  (256  + 64 * (j))
#define XB_XSUB(j)  (1280 + 64 * (j))
#define XB_XGEN(j)  (2304 + 64 * (j))
#define XB_TOP      3328
#define XB_TOPGEN   3392
#define XCD_BAR_WORDS 3456
#define XB_SPIN_CAP (1u << 18)
__device__ __forceinline__ unsigned xb_ld(unsigned* p)              { return __hip_atomic_load(p, __ATOMIC_RELAXED, __HIP_MEMORY_SCOPE_AGENT); }
__device__ __forceinline__ unsigned xb_add(unsigned* p, unsigned v) { return __hip_atomic_fetch_add(p, v, __ATOMIC_RELAXED, __HIP_MEMORY_SCOPE_AGENT); }
__device__ __forceinline__ unsigned xb_xcc_id() { return (unsigned)__builtin_amdgcn_s_getreg((3 << 11) | 20) & 0xFu; }
#define XB_SPIN(cond, bar) do { unsigned _sp = 0; while (cond) { __builtin_amdgcn_s_sleep(1); \
    if ((++_sp & 255u) == 0u) { if (xb_ld(&(bar)[XB_TMO])) break; if (_sp > XB_SPIN_CAP) { atomicAdd(&(bar)[XB_TMO], 1u); break; } } } } while (0)
struct XcdBarrier { unsigned* bar; unsigned x; volatile LAS unsigned* st; };
__device__ __forceinline__ XcdBarrier xcd_barrier_post(unsigned* bar, volatile LAS unsigned* st) {
    XcdBarrier b; b.bar = bar; b.x = xb_xcc_id(); b.st = st;
    if (threadIdx.x == 0) (void)xb_add(&bar[XB_XCNT(b.x)], 1u);
    return b;
}
__device__ __forceinline__ void xcd_barrier_complete(unsigned* bar, unsigned x, unsigned& nloc, unsigned& nx) {
    const unsigned G = gridDim.x * gridDim.y * gridDim.z;
    unsigned sum, cnt, mine, sp = 0u;
    for (;;) {
        sum = 0u; cnt = 0u; mine = 0u;
#pragma unroll
        for (unsigned j = 0; j < 16; ++j) { const unsigned c = xb_ld(&bar[XB_XCNT(j)]); sum += c; cnt += (c > 0u) ? 1u : 0u; mine = (j == x) ? c : mine; }
        if (sum == G) break;
        __builtin_amdgcn_s_sleep(1);
        if ((++sp & 255u) == 0u) { if (xb_ld(&bar[XB_TMO])) break; if (sp > XB_SPIN_CAP) { atomicAdd(&bar[XB_TMO], 1u); break; } }
    }
    nloc = mine > 0u ? mine : 1u; nx = cnt > 0u ? cnt : 1u;
}
__device__ __forceinline__ void xcd_barrier(const XcdBarrier& b) {
    asm volatile("s_waitcnt vmcnt(0)" ::: "memory");
    __syncthreads();
    if (threadIdx.x == 0) {
        unsigned* bar = b.bar;
        __builtin_amdgcn_s_waitcnt(0);
        unsigned nloc = b.st[0], nx = b.st[1];
        if (nloc == 0u) { xcd_barrier_complete(bar, b.x, nloc, nx); b.st[0] = nloc; b.st[1] = nx; }
        const unsigned old = xb_add(&bar[XB_XSUB(b.x)], 1u);
        const unsigned gen = old / nloc;
        if (old + 1u == (gen + 1u) * nloc) {
            __builtin_amdgcn_fence(__ATOMIC_RELEASE, "agent");
            asm volatile("s_waitcnt vmcnt(0)" ::: "memory");
            const unsigned og = xb_add(&bar[XB_TOP], 1u);
            const unsigned tg = og / nx;
            if (og + 1u == (tg + 1u) * nx) xb_add(&bar[XB_TOPGEN], 1u);
            else XB_SPIN(xb_ld(&bar[XB_TOPGEN]) == tg, bar);
            __builtin_amdgcn_fence(__ATOMIC_ACQUIRE, "agent");
            xb_add(&bar[XB_XGEN(b.x)], 1u);
            asm volatile("s_waitcnt vmcnt(0)" ::: "memory");
        } else {
            XB_SPIN(xb_ld(&bar[XB_XGEN(b.x)]) == gen, bar);
            __builtin_amdgcn_fence(__ATOMIC_ACQUIRE, "agent");
            asm volatile("s_waitcnt vmcnt(0)" ::: "memory");
        }
    }
    __syncthreads();
}

struct Args {
    const float* x; const int* pos; const float* w_in; const float* conv_w; const float* conv_b; const float* dt_bias; const float* a_log;
    const float* d_skip; const float* norm_w; const float* sinks; const float* w_out; const float* ln_g; const float* ln_b;
    float* out; unsigned char* ws; int ph_lo, ph_hi;
};
struct Frame {
    LAS unsigned char* lds; int tid, lane, wave, vcu, G;
    bf16 *w_in_t, *w_out_t, *xb, *proj, *xc; float *cosT, *sinT, *dt, *ssq;
};

__device__ __forceinline__ int win_src_col(int n) {
    if (n < 1024) return n; if (n < 2048) return OFF_Q + n - 1024; if (n < 3584) return OFF_XBC + n - 2048;
    if (n < 3840) return OFF_K + n - 3584; if (n < 4096) return OFF_V + n - 3840; return OFF_G + n - 4096;
}
__device__ __forceinline__ void transpose_item(const float* W, int ldw, int srccol0, float scale, bf16* WT, int ldk, int n0, int k0, LAS float* scr, int lane) {
#pragma unroll 8
    for (int i = 0; i < 32; ++i) { const int kk = 2 * i + (lane >> 5); scr[kk * 33 + (lane & 31)] = W[(size_t)(k0 + kk) * ldw + srccol0 + (lane & 31)] * scale; }
    LDS_WAIT(); asm volatile("" ::: "memory");
    const int c = lane & 7;
#pragma unroll
    for (int j = 0; j < 4; ++j) { const int n = (lane >> 3) + 8 * j; const LAS float* s = scr + (8 * c) * 33 + n;
        v4u o; o.x = pk2(s[0 * 33], s[1 * 33]); o.y = pk2(s[2 * 33], s[3 * 33]); o.z = pk2(s[4 * 33], s[5 * 33]); o.w = pk2(s[6 * 33], s[7 * 33]);
        *(GAS v4u*)(WT + (size_t)(n0 + n) * ldk + k0 + 8 * c) = o; }
    LDS_WAIT(); asm volatile("" ::: "memory");
}
__device__ __forceinline__ void p0_prologue(const Args& a, Frame& F) {
    LAS float* scr = (LAS float*)(F.lds + F.wave * 8448);
    const int gw = F.vcu * NWAVES + F.wave, NGW = F.G * NWAVES;
    constexpr int I_IN = (1024 / 64) * (5120 / 32), I_OUT = (2048 / 64) * (1024 / 32);
    for (int it = gw; it < I_IN + I_OUT; it += NGW) {
        if (it < I_IN) { const int nblk = 5120 / 32, kb = it / nblk, nb = it % nblk, n0 = 32 * nb;
            transpose_item(a.w_in, DIN, win_src_col(n0), (n0 >= 1024 && n0 < 2048) ? C2 : 1.0f, F.w_in_t, 1024, n0, 64 * kb, scr, F.lane); }
        else { const int r = it - I_IN, nblk = 1024 / 32, kb = r / nblk, nb = r % nblk;
            transpose_item(a.w_out, 1024, 32 * nb, 1.0f, F.w_out_t, 2048, 32 * nb, 64 * kb, scr, F.lane); }
    }
    __syncthreads();
    LAS float* wdt = (LAS float*)(F.lds);
    for (int i = F.tid; i < 16 * 1024; i += NTHREADS) { const int k = i >> 4, h = i & 15; wdt[h * 1024 + k] = a.w_in[(size_t)k * DIN + OFF_DT + h]; }
    __syncthreads();
    const int lane = F.lane;
    float myb = a.dt_bias[lane >> 2];
    for (int m = gw; m < MTOK; m += NGW) {
        const GAS f32x4* xr = (const GAS f32x4*)(a.x + (size_t)m * DMODEL) + lane;
        f32x4 v[4];
#pragma unroll
        for (int j = 0; j < 4; ++j) v[j] = xr[64 * j];
        GAS unsigned long long* o8 = (GAS unsigned long long*)(F.xb + (size_t)m * DMODEL) + lane;
#pragma unroll
        for (int j = 0; j < 4; ++j) o8[64 * j] = (unsigned long long)pk2(v[j].x, v[j].y) | ((unsigned long long)pk2(v[j].z, v[j].w) << 32);
        float acc[16];
#pragma unroll
        for (int h = 0; h < 16; ++h) { float s = 0.f;
#pragma unroll
            for (int j = 0; j < 4; ++j) { const f32x4 w = *(const LAS f32x4*)(wdt + h * 1024 + 256 * j + 4 * lane); s += (v[j].x * w.x + v[j].y * w.y) + (v[j].z * w.z + v[j].w * w.w); }
            acc[h] = s; if (h & 1) asm volatile("" ::: "memory"); }
        float r8[8], r4[4], r2[2], r1;
        const bool b5 = lane & 32, b4 = lane & 16, b3 = lane & 8, b2 = lane & 4;
#pragma unroll
        for (int i = 0; i < 8; ++i) { const float snd = b5 ? acc[i] : acc[i + 8], kp = b5 ? acc[i + 8] : acc[i]; r8[i] = kp + __shfl_xor(snd, 32); }
#pragma unroll
        for (int i = 0; i < 4; ++i) { const float snd = b4 ? r8[i] : r8[i + 4], kp = b4 ? r8[i + 4] : r8[i]; r4[i] = kp + __shfl_xor(snd, 16); }
#pragma unroll
        for (int i = 0; i < 2; ++i) { const float snd = b3 ? r4[i] : r4[i + 2], kp = b3 ? r4[i + 2] : r4[i]; r2[i] = kp + __shfl_xor(snd, 8); }
        { const float snd = b2 ? r2[0] : r2[1], kp = b2 ? r2[1] : r2[0]; r1 = kp + __shfl_xor(snd, 4); }
        r1 += __shfl_xor(r1, 1); r1 += __shfl_xor(r1, 2);
        const float pre = r1 + myb;
        const float dtv = pre > 20.f ? pre : log1pf(expf(pre));
        if ((lane & 3) == 0) F.dt[(size_t)m * 16 + (lane >> 2)] = dtv;
    }
    const int gt = F.vcu * NTHREADS + F.tid, GT = F.G * NTHREADS;
    for (int idx = gt; idx < MTOK * 8; idx += GT) {
        const int m = idx >> 3, i = idx & 7;
        const float inv = exp2f(-(float)i * 2.366446071165522f);
        const float ang = (float)a.pos[m] * inv;
        double rev = (double)ang * 0.15915494309189535; rev -= __builtin_rint(rev);
        F.cosT[idx] = __builtin_amdgcn_cosf((float)rev); F.sinT[idx] = __builtin_amdgcn_sinf((float)rev);
    }
}

__device__ __forceinline__ void p_rope(Frame& F) {
    const int gt = F.vcu * NTHREADS + F.tid, GT = F.G * NTHREADS;
    for (int item = gt; item < MTOK * 160; item += GT) {
        const int i = item & 7, hd = (item >> 3) % 20, m = item / 160;
        const int col = hd < 16 ? PC_Q + hd * 64 : PC_K + (hd - 16) * 64;
        bf16* p = F.proj + (size_t)m * LDP + col;
        const float r1 = bf2f(p[i]), r2 = bf2f(p[i + 8]), c = F.cosT[m * 8 + i], s = F.sinT[m * 8 + i];
        p[i] = (bf16)f2bf(r1 * c - r2 * s); p[i + 8] = (bf16)f2bf(r2 * c + r1 * s);
    }
}
__device__ __forceinline__ void p_conv(const Args& a, Frame& F) {
    const int gt = F.vcu * NTHREADS + F.tid, GT = F.G * NTHREADS;
    for (int item = gt; item < (MTOK / 16) * 192; item += GT) {
        const int cg = item % 192, rb = item / 192, r0 = rb * 16, ch = cg * 8;
        float w[4][8], bias[8], win[3][8];
#pragma unroll
        for (int k = 0; k < 4; ++k) { const f32x4 w0 = *(const f32x4*)(a.conv_w + k * DXBC + ch), w1 = *(const f32x4*)(a.conv_w + k * DXBC + ch + 4);
            w[k][0] = w0.x; w[k][1] = w0.y; w[k][2] = w0.z; w[k][3] = w0.w; w[k][4] = w1.x; w[k][5] = w1.y; w[k][6] = w1.z; w[k][7] = w1.w; }
        { const f32x4 b0 = *(const f32x4*)(a.conv_b + ch), b1 = *(const f32x4*)(a.conv_b + ch + 4);
            bias[0] = b0.x; bias[1] = b0.y; bias[2] = b0.z; bias[3] = b0.w; bias[4] = b1.x; bias[5] = b1.y; bias[6] = b1.z; bias[7] = b1.w; }
        const bool seq_start = (r0 & (SEQ - 1)) == 0;
#pragma unroll
        for (int k = 0; k < 3; ++k) {
            v4u q = (v4u){0u, 0u, 0u, 0u};
            if (!seq_start) q = *(const GAS v4u*)(F.proj + (size_t)(r0 - 3 + k) * LDP + PC_XBC + ch);
            win[k][0] = bflo(q.x); win[k][1] = bfhi(q.x); win[k][2] = bflo(q.y); win[k][3] = bfhi(q.y); win[k][4] = bflo(q.z); win[k][5] = bfhi(q.z); win[k][6] = bflo(q.w); win[k][7] = bfhi(q.w);
        }
#pragma unroll
        for (int r = 0; r < 16; ++r) {
            const v4u q = *(const GAS v4u*)(F.proj + (size_t)(r0 + r) * LDP + PC_XBC + ch);
            float cur[8] = {bflo(q.x), bfhi(q.x), bflo(q.y), bfhi(q.y), bflo(q.z), bfhi(q.z), bflo(q.w), bfhi(q.w)};
            float o[8];
#pragma unroll
            for (int e = 0; e < 8; ++e) { const float s = bias[e] + w[0][e] * win[0][e] + w[1][e] * win[1][e] + w[2][e] * win[2][e] + w[3][e] * cur[e]; o[e] = silu_f(s); }
            v4u ov; ov.x = pk2(o[0], o[1]); ov.y = pk2(o[2], o[3]); ov.z = pk2(o[4], o[5]); ov.w = pk2(o[6], o[7]);
            *(GAS v4u*)(F.xc + (size_t)(r0 + r) * DXBC + ch) = ov;
#pragma unroll
            for (int e = 0; e < 8; ++e) { win[0][e] = win[1][e]; win[1][e] = win[2][e]; win[2][e] = cur[e]; }
        }
    }
}
__device__ __forceinline__ void p_ssd_naive(const Args& a, Frame& F, float* yout) {
    LAS float* Bs = (LAS float*)F.lds; LAS float* Cs = Bs + 64 * 128; LAS float* xs = Cs + 64 * 128; LAS float* dts = xs + 64 * 64;
    const int tid = F.tid, p = tid >> 3, nq = tid & 7;
    for (int bh = F.vcu; bh < BATCH * NH; bh += F.G) {
        const int b = bh / NH, h = bh % NH, g = h >> 3;
        const float A = -expf(a.a_log[h]), Dk = a.d_skip[h];
        float st[16];
#pragma unroll
        for (int i = 0; i < 16; ++i) st[i] = 0.f;
        for (int c0 = 0; c0 < SEQ; c0 += 64) {
            __syncthreads();
            const size_t row0 = (size_t)b * SEQ + c0;
            for (int i = tid; i < 64 * 16; i += NTHREADS) { const int r = i >> 4, c8 = (i & 15) * 8;
                const v4u qb = *(const GAS v4u*)(F.xc + (row0 + r) * DXBC + 1024 + g * 128 + c8), qc = *(const GAS v4u*)(F.xc + (row0 + r) * DXBC + 1280 + g * 128 + c8);
                LAS float* bd = Bs + r * 128 + c8; LAS float* cd = Cs + r * 128 + c8;
                bd[0] = bflo(qb.x); bd[1] = bfhi(qb.x); bd[2] = bflo(qb.y); bd[3] = bfhi(qb.y); bd[4] = bflo(qb.z); bd[5] = bfhi(qb.z); bd[6] = bflo(qb.w); bd[7] = bfhi(qb.w);
                cd[0] = bflo(qc.x); cd[1] = bfhi(qc.x); cd[2] = bflo(qc.y); cd[3] = bfhi(qc.y); cd[4] = bflo(qc.z); cd[5] = bfhi(qc.z); cd[6] = bflo(qc.w); cd[7] = bfhi(qc.w); }
            { const int r = tid >> 3, c8 = (tid & 7) * 8; const v4u qx = *(const GAS v4u*)(F.xc + (row0 + r) * DXBC + h * 64 + c8); LAS float* xd = xs + r * 64 + c8;
                xd[0] = bflo(qx.x); xd[1] = bfhi(qx.x); xd[2] = bflo(qx.y); xd[3] = bfhi(qx.y); xd[4] = bflo(qx.z); xd[5] = bfhi(qx.z); xd[6] = bflo(qx.w); xd[7] = bfhi(qx.w); }
            if (tid < 64) dts[tid] = F.dt[(row0 + tid) * 16 + h];
            __syncthreads();
            for (int r = 0; r < 64; ++r) {
                const float dtv = dts[r], dA = expf(dtv * A), xp = xs[r * 64 + p], xdt = xp * dtv;
                float part = 0.f;
#pragma unroll
                for (int q4 = 0; q4 < 4; ++q4) { const f32x4 bv = *(const LAS f32x4*)(Bs + r * 128 + nq * 16 + 4 * q4), cv = *(const LAS f32x4*)(Cs + r * 128 + nq * 16 + 4 * q4);
                    st[4 * q4 + 0] = st[4 * q4 + 0] * dA + xdt * bv.x; part += st[4 * q4 + 0] * cv.x;
                    st[4 * q4 + 1] = st[4 * q4 + 1] * dA + xdt * bv.y; part += st[4 * q4 + 1] * cv.y;
                    st[4 * q4 + 2] = st[4 * q4 + 2] * dA + xdt * bv.z; part += st[4 * q4 + 2] * cv.z;
                    st[4 * q4 + 3] = st[4 * q4 + 3] * dA + xdt * bv.w; part += st[4 * q4 + 3] * cv.w; }
                part += __shfl_xor(part, 1); part += __shfl_xor(part, 2); part += __shfl_xor(part, 4);
                if (nq == 0) yout[(row0 + r) * 1024 + h * 64 + p] = part + Dk * xp;
            }
        }
    }
}
__device__ __forceinline__ void p_gate_norm(const Args& a, Frame& F, const float* yin) {
    const int gw = F.vcu * NWAVES + F.wave, NGW = F.G * NWAVES, lane = F.lane;
    for (int m = gw; m < MTOK; m += NGW) {
        const GAS f32x4* yr = (const GAS f32x4*)(yin + (size_t)m * 1024) + lane;
        GAS v2u* zr = (GAS v2u*)(F.proj + (size_t)m * LDP + PC_Z) + lane;
        float yg[16]; float ss0 = 0.f, ss1 = 0.f;
#pragma unroll
        for (int j = 0; j < 4; ++j) { const f32x4 yv = yr[64 * j]; const v2u zq = zr[64 * j];
            const float z0 = bflo(zq.x), z1 = bfhi(zq.x), z2 = bflo(zq.y), z3 = bfhi(zq.y);
            yg[4 * j + 0] = yv.x * z0; yg[4 * j + 1] = yv.y * z1; yg[4 * j + 2] = yv.z * z2; yg[4 * j + 3] = yv.w * z3;
            const float q = (yg[4 * j] * yg[4 * j] + yg[4 * j + 1] * yg[4 * j + 1]) + (yg[4 * j + 2] * yg[4 * j + 2] + yg[4 * j + 3] * yg[4 * j + 3]);
            if (j < 2) ss0 += q; else ss1 += q; }
        ss0 = wave_sum(ss0); ss1 = wave_sum(ss1);
        const float r0 = 1.f / sqrtf(ss0 * (1.f / 512.f) + RMS_EPS), r1 = 1.f / sqrtf(ss1 * (1.f / 512.f) + RMS_EPS);
#pragma unroll
        for (int j = 0; j < 4; ++j) { const f32x4 nw = *(const f32x4*)(a.norm_w + 256 * j + 4 * lane); const float rr = j < 2 ? r0 : r1;
            v2u o; o.x = pk2(yg[4 * j] * rr * nw.x, yg[4 * j + 1] * rr * nw.y); o.y = pk2(yg[4 * j + 2] * rr * nw.z, yg[4 * j + 3] * rr * nw.w); zr[64 * j] = o; }
    }
}
__device__ __forceinline__ void p_attn_naive(const Args& a, Frame& F) {
    const int gw = F.vcu * NWAVES + F.wave, NGW = F.G * NWAVES, lane = F.lane;
    for (int item = gw; item < MTOK * 16; item += NGW) {
        const int hq = item & 15, t = item >> 4, tl = t & (SEQ - 1), kvh = hq >> 2;
        bf16* qp = F.proj + (size_t)t * LDP + PC_Q + hq * 64 + lane;
        const float q = bf2f(*qp);
        float m2 = a.sinks[hq] * LOG2E, l = 1.f, acc = 0.f;
        const int nk = tl < 127 ? tl + 1 : 128;
        const bf16* kp = F.proj + (size_t)(t - nk + 1) * LDP + PC_K + kvh * 64 + lane;
        for (int j = 0; j < nk; ++j) {
            const float kv = bf2f(kp[(size_t)j * LDP]), vv = bf2f(kp[(size_t)j * LDP + (PC_V - PC_K)]);
            const float s = wave_sum(q * kv);
            const float mn = fmaxf(m2, s), f = exp2f(m2 - mn), pp = exp2f(s - mn);
            l = l * f + pp; acc = acc * f + pp * vv; m2 = mn;
        }
        const float gv = bf2f(F.proj[(size_t)t * LDP + PC_G + hq * 64 + lane]);
        *qp = (bf16)f2bf(acc / l * gv);
    }
}
__device__ __forceinline__ void p_attn(const Args& a, Frame& F) {
    static_assert(att::L_END <= RING_BYTES, "attention LDS map");
    for (int run = F.vcu; run < 256; run += F.G) { const int b = run >> 5, kvh = (run >> 3) & 3, nb0 = (run & 7) * 4;
        att::attn_run(F.proj, a.sinks, b, kvh, nb0, 4, (att::lds_ptr)F.lds, (unsigned)(size_t)F.lds); }
}
__device__ __forceinline__ void p_ln(const Args& a, Frame& F) {
    const int gw = F.vcu * NWAVES + F.wave, NGW = F.G * NWAVES, lane = F.lane;
    for (int m = gw; m < MTOK; m += NGW) {
        const GAS f32x4* xr = (const GAS f32x4*)(a.x + (size_t)m * DMODEL) + lane;
        GAS f32x4* hr = (GAS f32x4*)(a.out + (size_t)m * DMODEL) + lane;
        f32x4 v[4]; float s = 0.f;
#pragma unroll
        for (int j = 0; j < 4; ++j) { v[j] = xr[64 * j] * ALPHA + hr[64 * j]; s += (v[j].x + v[j].y) + (v[j].z + v[j].w); }
        const float mean = wave_sum(s) * (1.f / DMODEL); float s2 = 0.f;
#pragma unroll
        for (int j = 0; j < 4; ++j) { v[j] = v[j] - mean; s2 += (v[j].x * v[j].x + v[j].y * v[j].y) + (v[j].z * v[j].z + v[j].w * v[j].w); }
        const float rstd = 1.f / sqrtf(wave_sum(s2) * (1.f / DMODEL) + LN_EPS);
#pragma unroll
        for (int j = 0; j < 4; ++j) { const f32x4 gg = *(const f32x4*)(a.ln_g + 256 * j + 4 * lane), bb = *(const f32x4*)(a.ln_b + 256 * j + 4 * lane);
            hr[64 * j] = v[j] * rstd * gg + bb; }
    }
}

constexpr int N_PHASES = 9;
#ifndef MK_ONE_LAUNCH
#define MK_ONE_LAUNCH 1
#endif
__global__ void __launch_bounds__(NTHREADS, 2) mk_fwd(Args args) {
    extern __shared__ __attribute__((aligned(16))) unsigned char lds[];
    Frame F;
    F.lds = (LAS unsigned char*)lds;
    F.tid = threadIdx.x; F.lane = F.tid & 63; F.wave = __builtin_amdgcn_readfirstlane(F.tid >> 6);
    F.G = gridDim.x; { const int bx = blockIdx.x; F.vcu = (F.G % 8 == 0) ? (bx % 8) * (F.G / 8) + bx / 8 : bx; }
    unsigned char* ws = args.ws;
    F.w_in_t = (bf16*)(ws + WS_WIN); F.w_out_t = (bf16*)(ws + WS_WOUT); F.xb = (bf16*)(ws + WS_XB); F.proj = (bf16*)(ws + WS_PROJ); F.xc = (bf16*)(ws + WS_XC);
    F.cosT = (float*)(ws + WS_COS); F.sinT = (float*)(ws + WS_SIN); F.dt = (float*)(ws + WS_DT); F.ssq = (float*)(ws + WS_SSQ);
    volatile LAS unsigned* MISC = (volatile LAS unsigned*)(F.lds + MISC_OFF);
    for (int u = F.tid; u < (LDS_BYTES - LDSCTL_OFF) / 4; u += NTHREADS) ((LAS unsigned*)(F.lds + LDSCTL_OFF))[u] = 0u;
    __syncthreads();
    XcdBarrier bar; bar.bar = (unsigned*)(ws + WS_CTL) + CW_BAR; bar.x = 0; bar.st = nullptr;
    if (MK_ONE_LAUNCH) bar = xcd_barrier_post((unsigned*)(ws + WS_CTL) + CW_BAR, MISC + 8);
    const int lo = args.ph_lo, hi = args.ph_hi;
#define IN(k) (lo <= (k) && (k) < hi)
#define SEAM(k) do { if (IN(k) && IN((k) + 1)) xcd_barrier(bar); } while (0)
    if (IN(0)) { p0_prologue(args, F); SEAM(0); }
    if (IN(1)) {
        pg8::Gemm g{F.xb, F.w_in_t, MTOK, LDP, DMODEL, DMODEL, DMODEL}; pg8::StaticOrder S; S.init(MTOK, LDP, F.G, (int)blockIdx.x);
        pg8::EpiProj E{F.proj, LDP, F.cosT, F.sinT};
        pg8::gemm_phase<pg8::EpiProj, pg8::StaticOrder, true, true>(F.lds, g, S, E);
        SEAM(1);
    }
    if (IN(2)) { SEAM(2); }
    if (IN(3)) { p_conv(args, F); SEAM(3); }
    if (IN(4)) { p_ssd_naive(args, F, args.out); SEAM(4); }
    if (IN(5)) { p_gate_norm(args, F, args.out); SEAM(5); }
    if (IN(6)) { p_attn(args, F); SEAM(6); }
    if (IN(7)) {
        pg8::Gemm g{F.proj, F.w_out_t, MTOK, DMODEL, 2048, LDP, 2048}; pg8::StaticOrder S; S.init(MTOK, DMODEL, F.G, (int)blockIdx.x);
        pg8::EpiF32 E{args.out, DMODEL};
        pg8::gemm_phase<pg8::EpiF32, pg8::StaticOrder, true, true>(F.lds, g, S, E);
        SEAM(7);
    }
    if (IN(8)) { p_ln(args, F); }
#undef IN
#undef SEAM
}

extern "C" void kernel_launch(void* const* d_in, const int* in_sizes, int n_in, void* d_out, int out_size, void* d_ws, size_t ws_size, hipStream_t stream) {
    static int grid = 0;
    if (grid == 0) {
        if (n_in != 13 || in_sizes[0] != MTOK * DMODEL || out_size != MTOK * DMODEL || ws_size < WS_END) {
            fprintf(stderr, "kernel_launch: unexpected shapes (n_in %d, in0 %d, out %d, ws %zu); nothing launched\n", n_in, n_in > 0 ? in_sizes[0] : -1, out_size, ws_size); grid = -1; return; }
        int dev = 0, cus = 0;
        if (hipGetDevice(&dev) != hipSuccess || hipDeviceGetAttribute(&cus, hipDeviceAttributeMultiprocessorCount, dev) != hipSuccess) { grid = -1; return; }
        if (hipFuncSetAttribute((const void*)mk_fwd, hipFuncAttributeMaxDynamicSharedMemorySize, LDS_BYTES) != hipSuccess) { fprintf(stderr, "kernel_launch: hipFuncSetAttribute failed\n"); grid = -1; return; }
        int per_cu = 0;
        if (hipOccupancyMaxActiveBlocksPerMultiprocessor(&per_cu, (const void*)mk_fwd, NTHREADS, LDS_BYTES) != hipSuccess || per_cu < 1) fprintf(stderr, "kernel_launch: occupancy query reports %d\n", per_cu);
        (void)hipGetLastError();
        grid = cus;
    }
    if (grid < 0) return;
    if (hipMemsetAsync((char*)d_ws + WS_CTL, 0, CTL_ZERO_BYTES, stream) != hipSuccess) return;
    Args a{};
    a.x = (const float*)d_in[0]; a.pos = (const int*)d_in[1]; a.w_in = (const float*)d_in[2]; a.conv_w = (const float*)d_in[3]; a.conv_b = (const float*)d_in[4];
    a.dt_bias = (const float*)d_in[5]; a.a_log = (const float*)d_in[6]; a.d_skip = (const float*)d_in[7]; a.norm_w = (const float*)d_in[8]; a.sinks = (const float*)d_in[9];
    a.w_out = (const float*)d_in[10]; a.ln_g = (const float*)d_in[11]; a.ln_b = (const float*)d_in[12];
    a.out = (float*)d_out; a.ws = (unsigned char*)d_ws;
#if MK_ONE_LAUNCH
    a.ph_lo = 0; a.ph_hi = N_PHASES;
    hipLaunchKernelGGL(mk_fwd, dim3(grid), dim3(NTHREADS), LDS_BYTES, stream, a);
#else
    for (int p = 0; p < N_PHASES; ++p) { a.ph_lo = p; a.ph_hi = p + 1; hipLaunchKernelGGL(mk_fwd, dim3(grid), dim3(NTHREADS), LDS_BYTES, stream, a); }
#endif
}
```

```cpp
#include <hip/hip_runtime.h>
#include <cstdio>
#include <cstdint>
#include <cmath>
constexpr int BATCH = 8, SEQ = 4096, DMODEL = 1024, MTOK = BATCH * SEQ;
constexpr int NH = 16, HD = 64, NST = 128, DXBC = 1536;
constexpr int DIN = 5136, OFF_XBC = 1024, OFF_DT = 2560, OFF_Q = 2576, OFF_K = 3600, OFF_V = 3856, OFF_G = 4112;
constexpr int LDP = 5120, PC_Z = 0, PC_Q = 1024, PC_XBC = 2048, PC_K = 3584, PC_V = 3840, PC_G = 4096;
constexpr float ALPHA = 1.189207115002721f, LN_EPS = 1e-5f, RMS_EPS = 1e-5f;
constexpr float LOG2E = 1.4426950408889634f, C2 = 0.125f * LOG2E;

constexpr size_t MiB = 1u << 20;
constexpr size_t WS_CTL = 0, CTL_ZERO_BYTES = 1 * MiB;
constexpr size_t WS_WIN = 1 * MiB;
constexpr size_t WS_WOUT = 11 * MiB;
constexpr size_t WS_COS = 15 * MiB, WS_SIN = 16 * MiB;
constexpr size_t WS_DT = 17 * MiB;
constexpr size_t WS_SSQ = 19 * MiB;
constexpr size_t WS_XB = 24 * MiB;
constexpr size_t WS_PROJ = 88 * MiB;
constexpr size_t WS_XC = 408 * MiB;
constexpr size_t WS_END = 504 * MiB;

constexpr int CW_TMO = 0, CW_CODE = 1, CW_BAR = 4096;

constexpr int NWAVES = 8, NTHREADS = 512;
constexpr int RING_BYTES = 143360, LDSCTL_OFF = RING_BYTES, MISC_OFF = LDSCTL_OFF + 320, LDS_BYTES = 147456;

#define GAS __attribute__((address_space(1)))
#define LAS __attribute__((address_space(3)))
typedef unsigned short bf16;
typedef unsigned v4u __attribute__((ext_vector_type(4)));
typedef unsigned v2u __attribute__((ext_vector_type(2)));
typedef float f32x4 __attribute__((ext_vector_type(4)));
typedef GAS unsigned gu32;
#define RLX_AGENT __ATOMIC_RELAXED, __HIP_MEMORY_SCOPE_AGENT
#define LDS_WAIT() asm volatile("s_waitcnt lgkmcnt(0)" ::: "memory")
#define VM_WAIT() asm volatile("s_waitcnt vmcnt(0)" ::: "memory")
__device__ __forceinline__ unsigned f2bf(float f) { unsigned u = __builtin_bit_cast(unsigned, f); return (u + 0x7fffu + ((u >> 16) & 1u)) >> 16; }
__device__ __forceinline__ unsigned pk2(float lo, float hi) { return f2bf(lo) | (f2bf(hi) << 16); }
__device__ __forceinline__ float bf2f(unsigned u16) { return __builtin_bit_cast(float, u16 << 16); }
__device__ __forceinline__ float bflo(unsigned w) { return __builtin_bit_cast(float, w << 16); }
__device__ __forceinline__ float bfhi(unsigned w) { return __builtin_bit_cast(float, w & 0xffff0000u); }
__device__ __forceinline__ float wave_sum(float v) {
#pragma unroll
    for (int o = 1; o < 64; o <<= 1) v += __shfl_xor(v, o);
    return v;
}
__device__ __forceinline__ float silu_f(float v) { return v * __builtin_amdgcn_rcpf(1.f + __expf(-v)); }

namespace pg8 {
#define PG8_LAS __attribute__((address_space(3)))
typedef unsigned short bf16_t;
typedef short bf16x8 __attribute__((ext_vector_type(8)));
typedef float f32x4 __attribute__((ext_vector_type(4)));
typedef unsigned u32x4 __attribute__((ext_vector_type(4)));
constexpr int BM = 256, BK = 64, HALF = 128, HTB = HALF * BK * 2  , STAGE_BYTES = 8 * HTB, NXCD = 8, WGM = 8;

__host__ __device__ __forceinline__ int lds_byte(int r, int c) { const int st = (r >> 4) * 2 + (c >> 5), rr = r & 15, cc = c & 31, ob = rr * 64 + cc * 2; return st * 1024 + (ob ^ (((ob >> 9) & 1) << 5)); }
__host__ __device__ __forceinline__ void stage_rc(int b, int& R, int& C) { const int st = b / 1024, sb = b % 1024, swz = sb ^ (((sb >> 9) & 1) << 5); R = (st >> 1) * 16 + swz / 64; C = (st & 1) * 32 + (swz % 64) / 2; }
__host__ __device__ __forceinline__ int perm32(int rho) { const int n = rho >> 4, i = rho & 15; return 8 * (i >> 2) + 4 * n + (i & 3); }

struct Unit { int pm, pn; };
struct Gemm { const bf16_t* A; const bf16_t* Bt; int M, N, K, lda, ldb; };

struct StaticOrder {
    int nM, nN, nwg, G, c;
    __host__ __device__ void init(int M, int N, int G_, int c_) { nM = M / BM; nN = N / BM; nwg = nM * nN; G = G_; c = c_; }
    __host__ __device__ bool next(int i, Unit& u) const {
        const long L = (long)i * G + c; if (L >= nwg) return false;
        int wgid = (int)L; { const int q = nwg / NXCD, r = nwg % NXCD, xcd = wgid % NXCD, off = wgid / NXCD; wgid = (xcd < r ? xcd * (q + 1) : r * (q + 1) + (xcd - r) * q) + off; }
        const int nig = WGM * nN, gid = wgid / nig, fm = gid * WGM, gsz = (nM - fm) < WGM ? (nM - fm) : WGM;
        u.pm = fm + ((wgid % nig) % gsz); u.pn = (wgid % nig) / gsz; return true;
    }
};
struct OneUnitOrder {
    StaticOrder so; int rnd;
    __host__ __device__ bool next(int i, Unit& u) const { if (i != 0) return false; return so.next(rnd, u); }
};

__device__ __forceinline__ unsigned cvt_pk_bf16(float lo, float hi) { unsigned r; asm volatile("v_cvt_pk_bf16_f32 %0, %1, %2" : "=v"(r) : "v"(lo), "v"(hi)); return r; }
struct EpiBf16 {
    static constexpr bool PERM = true, AFTER_DRAIN = false;
    bf16_t* O; int ldc;
    __device__ __forceinline__ void operator()(const f32x4 (&acc)[2][2][4][2], const Unit& u, int wr, int wc, int fr, int fq) const {
        const int row0 = u.pm * BM + wr * 64 + fr; const int col0 = u.pn * BM + wc * 32 + 8 * fq;
#pragma unroll
        for (int ai = 0; ai < 2; ++ai)
#pragma unroll
            for (int m = 0; m < 4; ++m) { bf16_t* rowp = O + (size_t)(row0 + ai * HALF + m * 16) * ldc + col0;
#pragma unroll
                for (int bj = 0; bj < 2; ++bj) { const f32x4 v0 = acc[ai][bj][m][0], v1 = acc[ai][bj][m][1];
                    u32x4 w; w.x = cvt_pk_bf16(v0[0], v0[1]); w.y = cvt_pk_bf16(v0[2], v0[3]); w.z = cvt_pk_bf16(v1[0], v1[1]); w.w = cvt_pk_bf16(v1[2], v1[3]);
                    *(u32x4*)(rowp + bj * HALF) = w; } }
    }
};
struct EpiF32 {
    static constexpr bool PERM = false, AFTER_DRAIN = false;
    float* O; int ldc;
    __device__ __forceinline__ void operator()(const f32x4 (&acc)[2][2][4][2], const Unit& u, int wr, int wc, int fr, int fq) const {
        const int col0 = u.pn * BM + wc * 32 + 4 * fq;
#pragma unroll
        for (int ai = 0; ai < 2; ++ai)
#pragma unroll
            for (int m = 0; m < 4; ++m) { const int r = ai * HALF + wr * 64 + m * 16 + fr; float* rowp = O + (size_t)(u.pm * BM + r) * ldc + col0;
#pragma unroll
                for (int bj = 0; bj < 2; ++bj)
#pragma unroll
                    for (int n = 0; n < 2; ++n) *(f32x4*)(rowp + bj * HALF + n * 16) = acc[ai][bj][m][n]; }
    }
};
struct EpiProj {
    static constexpr bool PERM = true, AFTER_DRAIN = false;
    bf16_t* O; int ldc; const float* cosT; const float* sinT;
    __device__ __forceinline__ void operator()(const f32x4 (&acc)[2][2][4][2], const Unit& u, int wr, int wc, int fr, int fq) const {
        const int row0 = u.pm * BM + wr * 64 + fr; const int col0 = u.pn * BM + wc * 32 + 8 * fq;
        const int pn = u.pn;
        const bool is_silu = pn < 4 || pn >= 16;
        const bool is_rope = ((pn >= 4 && pn < 8) || pn == 14) && ((wc & 1) == 0);
        const float sgn = fq == 0 ? -1.f : (fq == 1 ? 1.f : 0.f);
#pragma unroll
        for (int ai = 0; ai < 2; ++ai)
#pragma unroll
            for (int m = 0; m < 4; ++m) { const int row = row0 + ai * HALF + m * 16; bf16_t* rowp = O + (size_t)row * ldc + col0;
                f32x4 c0 = (f32x4){1.f, 1.f, 1.f, 1.f}, c1 = c0, s0 = (f32x4){0.f, 0.f, 0.f, 0.f}, s1 = s0;
                if (is_rope) { c0 = *(const f32x4*)(cosT + (size_t)row * 8); c1 = *(const f32x4*)(cosT + (size_t)row * 8 + 4); s0 = *(const f32x4*)(sinT + (size_t)row * 8); s1 = *(const f32x4*)(sinT + (size_t)row * 8 + 4);
                    if (fq >= 2) { c0 = (f32x4){1.f, 1.f, 1.f, 1.f}; c1 = c0; } s0 = s0 * sgn; s1 = s1 * sgn; }
#pragma unroll
                for (int bj = 0; bj < 2; ++bj) { f32x4 v0 = acc[ai][bj][m][0], v1 = acc[ai][bj][m][1];
                    if (is_silu) {
#pragma unroll
                        for (int e = 0; e < 4; ++e) { v0[e] = v0[e] * __builtin_amdgcn_rcpf(1.f + __expf(-v0[e])); v1[e] = v1[e] * __builtin_amdgcn_rcpf(1.f + __expf(-v1[e])); }
                    } else if (is_rope) {
                        f32x4 p0, p1;
#pragma unroll
                        for (int e = 0; e < 4; ++e) { p0[e] = __shfl_xor(v0[e], 16); p1[e] = __shfl_xor(v1[e], 16); }
                        v0 = v0 * c0 + p0 * s0; v1 = v1 * c1 + p1 * s1;
                    }
                    u32x4 w; w.x = cvt_pk_bf16(v0[0], v0[1]); w.y = cvt_pk_bf16(v0[2], v0[3]); w.z = cvt_pk_bf16(v1[0], v1[1]); w.w = cvt_pk_bf16(v1[2], v1[3]);
                    *(u32x4*)(rowp + bj * HALF) = w; } }
    }
};
template <class Epi, class Sched, bool ALIGN_EPI = false, bool SP2 = false>
__device__ __forceinline__ void gemm_phase(PG8_LAS unsigned char* lds, const Gemm g, const Sched& S, const Epi& E) {
    const int tid = threadIdx.x, wid = __builtin_amdgcn_readfirstlane(tid >> 6), lane = tid & 63, wr = wid >> 2, wc = wid & 3, fr = lane & 15, fq = lane >> 4;
    const int K = g.K, nt = K / BK;
    unsigned voffA[2], voffB[2];
#pragma unroll
    for (int i = 0; i < 2; ++i) { int R, C; stage_rc(tid * 16 + i * 8192, R, C); const int Rb = Epi::PERM ? ((R & ~31) + perm32(R & 31)) : R;
        voffA[i] = (unsigned)(R * g.lda + C) * 2u; voffB[i] = (unsigned)(Rb * g.ldb + C) * 2u; }
    const size_t kstep = (size_t)(BK * 2);
    const size_t hstepA = (size_t)HALF * g.lda * 2, hstepB = (size_t)HALF * g.ldb * 2;
    const size_t tstepA = 2 * hstepA, tstepB = 2 * hstepB;
    const unsigned ldsw = (unsigned)wid * 1024u;
    const int aoff = lds_byte(wr * 64 + fr, fq * 8), boff = lds_byte(wc * 32 + fr, fq * 8);
#define PG8_SA(b, h) (((b) * 2 + (h)) * HTB)
#define PG8_SB(b, h) ((4 + (b) * 2 + (h)) * HTB)
#define PG8_STAGE(bufoff, gbase, voff) do { _Pragma("unroll") for (int _i = 0; _i < 2; ++_i) \
        __builtin_amdgcn_global_load_lds((const unsigned*)((const char*)(gbase) + (voff)[_i]), (PG8_LAS unsigned*)(lds + (bufoff) + ldsw + _i * 8192), 16, 0, 0); } while (0)
#define PG8_LDA(dst, b, h) do { _Pragma("unroll") for (int m = 0; m < 4; ++m) _Pragma("unroll") for (int k = 0; k < 2; ++k) dst[m][k] = *(const PG8_LAS bf16x8*)(lds + PG8_SA(b, h) + aoff + m * 2048 + k * 1024); } while (0)
#define PG8_LDB(dst, b, h) do { _Pragma("unroll") for (int n = 0; n < 2; ++n) _Pragma("unroll") for (int k = 0; k < 2; ++k) dst[n][k] = *(const PG8_LAS bf16x8*)(lds + PG8_SB(b, h) + boff + n * 2048 + k * 1024); } while (0)
#define PG8_MMA(ai, bj, At, Bt) do { __builtin_amdgcn_s_setprio(1); _Pragma("unroll") for (int m = 0; m < 4; ++m) _Pragma("unroll") for (int n = 0; n < 2; ++n) _Pragma("unroll") for (int k = 0; k < 2; ++k) \
        acc[ai][bj][m][n] = __builtin_amdgcn_mfma_f32_16x16x32_bf16(Bt[n][k], At[m][k], acc[ai][bj][m][n], 0, 0, 0); __builtin_amdgcn_s_setprio(0); } while (0)
#define PG8_WAIT_V(n) asm volatile("s_waitcnt vmcnt(" #n ")" ::: "memory")
#define PG8_WAIT_L(n) asm volatile("s_waitcnt lgkmcnt(" #n ")" ::: "memory")
#define PG8_BAR __builtin_amdgcn_s_barrier()
#define PG8_SCHED __builtin_amdgcn_sched_barrier(0)
    Unit cur, nxt; int ui = 0;
    if (!S.next(0, cur)) return;
    f32x4 acc[2][2][4][2];
#pragma unroll
    for (int a = 0; a < 2; ++a)
#pragma unroll
        for (int b = 0; b < 2; ++b)
#pragma unroll
            for (int m = 0; m < 4; ++m)
#pragma unroll
                for (int n = 0; n < 2; ++n) acc[a][b][m][n] = (f32x4){0.f, 0.f, 0.f, 0.f};
    bf16x8 At[4][2], B0[2][2], B1[2][2];
    const char* cA = (const char*)g.A + (size_t)cur.pm * tstepA; const char* cB = (const char*)g.Bt + (size_t)cur.pn * tstepB;
    if constexpr (SP2) {
        PG8_STAGE(PG8_SB(0, 0), cB, voffB); PG8_STAGE(PG8_SB(0, 1), cB + hstepB, voffB); PG8_STAGE(PG8_SA(0, 0), cA, voffA); PG8_STAGE(PG8_SA(0, 1), cA + hstepA, voffA);
        if (wr == 1) PG8_BAR;
        PG8_WAIT_V(2); PG8_BAR;
        PG8_STAGE(PG8_SB(1, 0), cB + kstep, voffB); PG8_STAGE(PG8_SA(1, 0), cA + kstep, voffA); PG8_STAGE(PG8_SB(1, 1), cB + hstepB + kstep, voffB);
        PG8_WAIT_V(6); PG8_BAR;
    } else {
        PG8_STAGE(PG8_SB(0, 0), cB, voffB); PG8_STAGE(PG8_SA(0, 0), cA, voffA); PG8_STAGE(PG8_SB(0, 1), cB + hstepB, voffB); PG8_STAGE(PG8_SA(0, 1), cA + hstepA, voffA);
        if (wr == 1) PG8_BAR;
        PG8_WAIT_V(4); PG8_BAR;
        PG8_STAGE(PG8_SB(1, 0), cB + kstep, voffB); PG8_STAGE(PG8_SA(1, 0), cA + kstep, voffA); PG8_STAGE(PG8_SB(1, 1), cB + hstepB + kstep, voffB);
        PG8_WAIT_V(6); PG8_BAR;
    }
    for (;;) {
        const bool has_next = S.next(ui + 1, nxt);
        const char* nA = has_next ? (const char*)g.A + (size_t)nxt.pm * tstepA : cA; const char* nB = has_next ? (const char*)g.Bt + (size_t)nxt.pn * tstepB : cB;
        for (int t = 0; t < nt; t += 2) {
            const bool last = (t == nt - 2);
            const char* a1 = cA + (size_t)(t + 1) * kstep;
            const char* a2 = last ? nA : cA + (size_t)(t + 2) * kstep; const char* b2 = last ? nB : cB + (size_t)(t + 2) * kstep;
            const char* a3 = a2 + kstep; const char* b3 = b2 + kstep;
            if constexpr (SP2) {
            PG8_LDB(B0, 0, 0); PG8_LDB(B1, 0, 1); PG8_SCHED; PG8_LDA(At, 0, 0); PG8_STAGE(PG8_SA(1, 1), a1 + hstepA, voffA);
            PG8_WAIT_V(8); PG8_WAIT_L(0); PG8_BAR; PG8_MMA(0, 0, At, B0); PG8_MMA(0, 1, At, B1); PG8_BAR; PG8_SCHED;
            PG8_LDA(At, 0, 1); PG8_STAGE(PG8_SB(0, 0), b2, voffB); PG8_STAGE(PG8_SB(0, 1), b2 + hstepB, voffB); PG8_STAGE(PG8_SA(0, 0), a2, voffA);
            PG8_WAIT_V(8); PG8_WAIT_L(0); PG8_BAR; PG8_MMA(1, 0, At, B0); PG8_MMA(1, 1, At, B1); PG8_BAR; PG8_SCHED;
            PG8_LDB(B0, 1, 0); PG8_LDB(B1, 1, 1); PG8_SCHED; PG8_LDA(At, 1, 0); PG8_STAGE(PG8_SA(0, 1), a2 + hstepA, voffA);
            PG8_WAIT_V(8); PG8_WAIT_L(0); PG8_BAR; PG8_MMA(0, 0, At, B0); PG8_MMA(0, 1, At, B1); PG8_BAR; PG8_SCHED;
            PG8_LDA(At, 1, 1); PG8_STAGE(PG8_SB(1, 0), b3, voffB); PG8_STAGE(PG8_SB(1, 1), b3 + hstepB, voffB); PG8_STAGE(PG8_SA(1, 0), a3, voffA);
            PG8_WAIT_V(8); PG8_WAIT_L(0); PG8_BAR; PG8_MMA(1, 0, At, B0); PG8_MMA(1, 1, At, B1); PG8_BAR; PG8_SCHED;
            } else {
            PG8_LDB(B0, 0, 0); PG8_SCHED; PG8_LDA(At, 0, 0); PG8_STAGE(PG8_SA(1, 1), a1 + hstepA, voffA);
            PG8_WAIT_L(8); PG8_BAR; PG8_WAIT_L(0); PG8_MMA(0, 0, At, B0); PG8_BAR; PG8_SCHED;
            PG8_LDB(B1, 0, 1); PG8_STAGE(PG8_SB(0, 0), b2, voffB);
            PG8_BAR; PG8_WAIT_L(0); PG8_MMA(0, 1, At, B1); PG8_BAR;
            PG8_LDA(At, 0, 1); PG8_STAGE(PG8_SA(0, 0), a2, voffA);
            PG8_BAR; PG8_WAIT_L(0); PG8_MMA(1, 0, At, B0); PG8_BAR; PG8_SCHED;
            PG8_STAGE(PG8_SB(0, 1), b2 + hstepB, voffB);
            PG8_WAIT_V(6); PG8_BAR; PG8_MMA(1, 1, At, B1); PG8_BAR;
            PG8_LDB(B0, 1, 0); PG8_SCHED; PG8_LDA(At, 1, 0); PG8_STAGE(PG8_SA(0, 1), a2 + hstepA, voffA);
            PG8_WAIT_L(8); PG8_BAR; PG8_WAIT_L(0); PG8_MMA(0, 0, At, B0); PG8_BAR; PG8_SCHED;
            PG8_LDB(B1, 1, 1); PG8_STAGE(PG8_SB(1, 0), b3, voffB);
            PG8_BAR; PG8_WAIT_L(0); PG8_MMA(0, 1, At, B1); PG8_BAR;
            PG8_LDA(At, 1, 1); PG8_STAGE(PG8_SA(1, 0), a3, voffA);
            PG8_BAR; PG8_WAIT_L(0); PG8_MMA(1, 0, At, B0); PG8_BAR; PG8_SCHED;
            PG8_STAGE(PG8_SB(1, 1), b3 + hstepB, voffB);
            PG8_WAIT_V(6); PG8_BAR; PG8_MMA(1, 1, At, B1); PG8_BAR;
            }
        }
        if constexpr (ALIGN_EPI) { if (wr == 0) PG8_BAR; }
        if constexpr (!Epi::AFTER_DRAIN) { E(acc, cur, wr, wc, fr, fq); }
        if (!has_next) break;
#pragma unroll
        for (int a = 0; a < 2; ++a)
#pragma unroll
            for (int b = 0; b < 2; ++b)
#pragma unroll
                for (int m = 0; m < 4; ++m)
#pragma unroll
                    for (int n = 0; n < 2; ++n) acc[a][b][m][n] = (f32x4){0.f, 0.f, 0.f, 0.f};
        cur = nxt; cA = nA; cB = nB; ++ui;
        if constexpr (ALIGN_EPI) { if (wr == 1) PG8_BAR; }
    }
    PG8_WAIT_V(0);
    if constexpr (!ALIGN_EPI) { if (wr == 0) PG8_BAR; }
    PG8_BAR;
    if constexpr (Epi::AFTER_DRAIN) { E.fused(acc, cur, wr, wc, fr, fq, lds, wid, lane); }
#undef PG8_SA
#undef PG8_SB
#undef PG8_STAGE
#undef PG8_LDA
#undef PG8_LDB
#undef PG8_MMA
#undef PG8_WAIT_V
#undef PG8_WAIT_L
#undef PG8_BAR
#undef PG8_SCHED
}
}
namespace att {
typedef __attribute__((ext_vector_type(8))) short bf16x8;
typedef __attribute__((ext_vector_type(4))) short s16x4;
typedef __attribute__((ext_vector_type(16))) float f32x16;
typedef __attribute__((ext_vector_type(4))) unsigned u32x4;
typedef short v4i16_t __attribute__((ext_vector_type(4)));
typedef float f32x2_t __attribute__((ext_vector_type(2))); typedef __bf16 bf16x2_t __attribute__((ext_vector_type(2)));
typedef __attribute__((address_space(3))) const char* lds_cptr;
typedef __attribute__((address_space(3))) char* lds_ptr;
constexpr int BLKB = 32768, KTB = 8192;
#define SBAR() __builtin_amdgcn_sched_barrier(0)
constexpr int L_SCR = 3 * BLKB, L_OST = L_SCR + 8 * 256, L_END = L_OST + 8 * 4096;
__device__ __forceinline__ int crow(int r, int hi) { return (r & 3) + 8 * (r >> 2) + 4 * hi; }
__device__ __forceinline__ void glds16(const void* gsrc, unsigned lds_dst) { unsigned keep;
    asm volatile("s_mov_b32 %0, m0\n\ts_mov_b32 m0, %2\n\ts_nop 0\n\tglobal_load_lds_dwordx4 %1, off\n\ts_mov_b32 m0, %0" : "=&s"(keep) : "v"(gsrc), "s"(lds_dst) : "memory"); }
__device__ __forceinline__ unsigned cvtpk(float lo, float hi) { f32x2_t v = {lo, hi}; bf16x2_t b = __builtin_convertvector(v, bf16x2_t); return __builtin_bit_cast(unsigned, b); }
__device__ __forceinline__ s16x4 vtr(lds_cptr p) { return __builtin_bit_cast(s16x4, __builtin_amdgcn_ds_read_tr16_b64_v4i16((__attribute__((address_space(3))) v4i16_t*)p)); }
__device__ __forceinline__ float swapmax(float m) { auto rr = __builtin_amdgcn_permlane32_swap(__float_as_uint(m), __float_as_uint(m), false, false); return fmaxf(__uint_as_float(rr[0]), __uint_as_float(rr[1])); }
__device__ __forceinline__ float swapadd(float m) { auto rr = __builtin_amdgcn_permlane32_swap(__float_as_uint(m), __float_as_uint(m), false, false); return __uint_as_float(rr[0]) + __uint_as_float(rr[1]); }

__device__ __forceinline__ void dma_block(const unsigned short* proj, size_t row0, int kvh, unsigned slot, int wid, int lane) {
    const unsigned short* kb = proj + row0 * LDP + PC_K + kvh * 64 + (size_t)lane * LDP + wid * 8;
    const unsigned short* vb = proj + row0 * LDP + PC_V + kvh * 64 + (size_t)(16 * (wid & 3) + (lane >> 2)) * LDP + (wid >> 2) * 32 + (lane & 3) * 8;
    const unsigned d = (unsigned)__builtin_amdgcn_readfirstlane((int)(slot + wid * 1024));
    glds16(kb, d); glds16(kb + (size_t)64 * LDP, d + KTB); glds16(vb, d + 2 * KTB); glds16(vb + (size_t)64 * LDP, d + 3 * KTB);
}
__device__ __forceinline__ void qkt(f32x16& p0, f32x16& p1, lds_cptr kt, const bf16x8* qr, int r32, int hi) {
    lds_cptr kb = kt + hi * 1024 + r32 * 16;
    const f32x16 z = {};
#pragma unroll
    for (int d0 = 0; d0 < 4; ++d0) {
        const bf16x8 b0 = *(const __attribute__((address_space(3))) bf16x8*)(kb + d0 * 2048);
        const bf16x8 b1 = *(const __attribute__((address_space(3))) bf16x8*)(kb + d0 * 2048 + 512);
        if (d0 == 0) { p0 = __builtin_amdgcn_mfma_f32_32x32x16_bf16(b0, qr[0], z, 0, 0, 0); p1 = __builtin_amdgcn_mfma_f32_32x32x16_bf16(b1, qr[0], z, 0, 0, 0); }
        else { p0 = __builtin_amdgcn_mfma_f32_32x32x16_bf16(b0, qr[d0], p0, 0, 0, 0); p1 = __builtin_amdgcn_mfma_f32_32x32x16_bf16(b1, qr[d0], p1, 0, 0, 0); } }
}
__device__ __forceinline__ void pv(f32x16* o, int vb, const u32x4* pw) {
#pragma unroll
    for (int d0 = 0; d0 < 2; ++d0) { s16x4 lo[4], hh[4];
#pragma unroll
        for (int ks = 0; ks < 4; ++ks) {
            asm volatile("ds_read_b64_tr_b16 %0,%1 offset:%c2" : "=&v"(lo[ks]) : "v"(vb), "i"(d0 * 4096 + ks * 1024) : "memory");
            asm volatile("ds_read_b64_tr_b16 %0,%1 offset:%c2" : "=&v"(hh[ks]) : "v"(vb), "i"(d0 * 4096 + ks * 1024 + 512) : "memory"); }
        asm volatile("s_waitcnt lgkmcnt(0)" ::: "memory"); SBAR();
#pragma unroll
        for (int ks = 0; ks < 4; ++ks) { const bf16x8 vf = (bf16x8){lo[ks][0], lo[ks][1], lo[ks][2], lo[ks][3], hh[ks][0], hh[ks][1], hh[ks][2], hh[ks][3]};
            o[d0] = __builtin_amdgcn_mfma_f32_32x32x16_bf16(__builtin_bit_cast(bf16x8, pw[ks]), vf, o[d0], 0, 0, 0); }
    }
}
__device__ __forceinline__ void pack_tile(u32x4* pw, const f32x16& p0, const f32x16& p1) {
    pw[0] = (u32x4){cvtpk(p0[0], p0[1]), cvtpk(p0[2], p0[3]), cvtpk(p0[4], p0[5]), cvtpk(p0[6], p0[7])};
    pw[1] = (u32x4){cvtpk(p0[8], p0[9]), cvtpk(p0[10], p0[11]), cvtpk(p0[12], p0[13]), cvtpk(p0[14], p0[15])};
    pw[2] = (u32x4){cvtpk(p1[0], p1[1]), cvtpk(p1[2], p1[3]), cvtpk(p1[4], p1[5]), cvtpk(p1[6], p1[7])};
    pw[3] = (u32x4){cvtpk(p1[8], p1[9]), cvtpk(p1[10], p1[11]), cvtpk(p1[12], p1[13]), cvtpk(p1[14], p1[15])};
}
__device__ __forceinline__ void group32(const bf16x8* qr, lds_cptr k0, lds_cptr k1, lds_cptr k2, int v0, int v1, int v2, bool dead0, bool dead1, int qrel0, float sink2,
                                        unsigned short* qout, const unsigned short* gin, lds_ptr wsf_b, lds_ptr stg_b, int lane) {
    const int r32 = lane & 31, hi = lane >> 5; int qrel = qrel0 + r32; asm volatile("" : "+v"(qrel));
    const int vlane = ((lane >> 4) & 1) * 32 + (lane & 3) * 8 + (4 * hi + ((lane & 15) >> 2)) * 64;
    const float NEG = -INFINITY;
    f32x16 a0, a1, b0, b1, c0, c1;
    SBAR(); qkt(a0, a1, k0, qr, r32, hi); SBAR(); qkt(b0, b1, k1, qr, r32, hi); SBAR(); qkt(c0, c1, k2, qr, r32, hi); SBAR();
#pragma unroll
    for (int r = 0; r < 16; ++r) { const int kv = crow(r, hi);
        if (dead0 || !(kv > qrel)) a0[r] = NEG; if (dead0 || !(kv + 32 > qrel)) a1[r] = NEG;
        if (dead1) { b0[r] = NEG; b1[r] = NEG; }
        if (!(kv <= qrel)) c0[r] = NEG; if (!(kv + 32 <= qrel)) c1[r] = NEG; }
    SBAR();
    float mx = sink2;
#pragma unroll
    for (int r = 0; r < 16; ++r) { mx = fmaxf(mx, fmaxf(fmaxf(a0[r], a1[r]), fmaxf(fmaxf(b0[r], b1[r]), fmaxf(c0[r], c1[r])))); }
    mx = swapmax(mx);
    float rs = 0.f;
#pragma unroll
    for (int r = 0; r < 16; ++r) { a0[r] = __builtin_amdgcn_exp2f(a0[r] - mx); a1[r] = __builtin_amdgcn_exp2f(a1[r] - mx); b0[r] = __builtin_amdgcn_exp2f(b0[r] - mx); b1[r] = __builtin_amdgcn_exp2f(b1[r] - mx);
        c0[r] = __builtin_amdgcn_exp2f(c0[r] - mx); c1[r] = __builtin_amdgcn_exp2f(c1[r] - mx); rs += (a0[r] + a1[r]) + (b0[r] + b1[r]) + (c0[r] + c1[r]); }
    SBAR();
    const float l = swapadd(rs) + __builtin_amdgcn_exp2f(sink2 - mx);
    f32x16 o[2]; o[0] = f32x16{}; o[1] = f32x16{};
    u32x4 pw[4];
    SBAR(); pack_tile(pw, a0, a1); pv(o, v0 + vlane, pw);
    SBAR(); pack_tile(pw, b0, b1); pv(o, v1 + vlane, pw);
    SBAR(); pack_tile(pw, c0, c1); pv(o, v2 + vlane, pw); SBAR();
    __attribute__((address_space(3))) float* wsf = (__attribute__((address_space(3))) float*)wsf_b;
    if (hi == 0) wsf[r32] = __builtin_amdgcn_rcpf(l);
    asm volatile("s_waitcnt lgkmcnt(0)" ::: "memory");
    __attribute__((address_space(3))) unsigned short* stg = (__attribute__((address_space(3))) unsigned short*)stg_b;
    __attribute__((address_space(3))) float* wsfl = wsf + 4 * hi; asm volatile("" : "+v"(wsfl));
    __attribute__((address_space(3))) unsigned short* stgl = stg + 4 * hi * 64 + r32; asm volatile("" : "+v"(stgl));
#pragma unroll
    for (int r = 0; r < 16; ++r) { const int ro = (r & 3) + 8 * (r >> 2); const float rl = wsfl[ro];
        stgl[ro * 64] = (unsigned short)(cvtpk(o[0][r] * rl, 0.f) & 0xffffu); stgl[ro * 64 + 32] = (unsigned short)(cvtpk(o[1][r] * rl, 0.f) & 0xffffu); }
    asm volatile("s_waitcnt lgkmcnt(0)" ::: "memory");
#pragma unroll
    for (int i = 0; i < 4; ++i) { const int row = i * 8 + (lane >> 3), ch = lane & 7;
        const u32x4 ov = *(const __attribute__((address_space(3))) u32x4*)(stg + row * 64 + ch * 8);
        const u32x4 gv = *(const u32x4*)(gin + (size_t)row * LDP + ch * 8);
        u32x4 w;
        w.x = cvtpk(__uint_as_float(ov.x << 16) * __uint_as_float(gv.x << 16), __uint_as_float(ov.x & 0xffff0000u) * __uint_as_float(gv.x & 0xffff0000u));
        w.y = cvtpk(__uint_as_float(ov.y << 16) * __uint_as_float(gv.y << 16), __uint_as_float(ov.y & 0xffff0000u) * __uint_as_float(gv.y & 0xffff0000u));
        w.z = cvtpk(__uint_as_float(ov.z << 16) * __uint_as_float(gv.z << 16), __uint_as_float(ov.z & 0xffff0000u) * __uint_as_float(gv.z & 0xffff0000u));
        w.w = cvtpk(__uint_as_float(ov.w << 16) * __uint_as_float(gv.w << 16), __uint_as_float(ov.w & 0xffff0000u) * __uint_as_float(gv.w & 0xffff0000u));
        *(u32x4*)(qout + (size_t)row * LDP + ch * 8) = w; }
    asm volatile("s_waitcnt lgkmcnt(0)" ::: "memory");
}
__device__ __forceinline__ void attn_run(unsigned short* proj, const float* sinks, int b, int kvh, int nb0, int cnt, lds_ptr shm, unsigned lds0) {
    const int tid = threadIdx.x, lane = tid & 63, r32 = lane & 31, hi = lane >> 5; const int wid = __builtin_amdgcn_readfirstlane(tid >> 6);
    const int hq = kvh * 4 + (wid >> 1), th = wid & 1;
    const float sink2 = sinks[hq] * LOG2E;
    const size_t rowb = (size_t)b * SEQ;
    asm volatile("s_waitcnt vmcnt(0) lgkmcnt(0)\n\ts_barrier" ::: "memory");
    if (nb0 > 0) dma_block(proj, rowb + (size_t)(nb0 - 1) * 128, kvh, lds0 + ((nb0 + 2) % 3) * BLKB, wid, lane);
    else { __attribute__((address_space(3))) u32x4* z = (__attribute__((address_space(3))) u32x4*)(shm + 2 * BLKB);
#pragma unroll
        for (int i = 0; i < 4; ++i) z[tid + 512 * i] = (u32x4){0u, 0u, 0u, 0u}; }
    dma_block(proj, rowb + (size_t)nb0 * 128, kvh, lds0 + (nb0 % 3) * BLKB, wid, lane);
    for (int nb = nb0; nb < nb0 + cnt; ++nb) {
        const int sprev = (nb + 2) % 3, scur = nb % 3, snext = (nb + 1) % 3;
        const size_t row0 = rowb + (size_t)nb * 128 + 64 * th;
        unsigned short* qbase = proj + row0 * LDP + PC_Q + hq * 64;
        const unsigned short* gbase = proj + row0 * LDP + PC_G + hq * 64;
        bf16x8 qa[4], qb[4];
#pragma unroll
        for (int d0 = 0; d0 < 4; ++d0) { qa[d0] = *(const bf16x8*)(qbase + (size_t)r32 * LDP + d0 * 16 + hi * 8); qb[d0] = *(const bf16x8*)(qbase + (size_t)(32 + r32) * LDP + d0 * 16 + hi * 8); }
        asm volatile("" : "+v"(qa[0]), "+v"(qa[1]), "+v"(qa[2]), "+v"(qa[3]), "+v"(qb[0]), "+v"(qb[1]), "+v"(qb[2]), "+v"(qb[3]));
        asm volatile("s_waitcnt vmcnt(0) lgkmcnt(0)\n\ts_barrier" ::: "memory");
        if (nb + 1 < nb0 + cnt) dma_block(proj, rowb + (size_t)(nb + 1) * 128, kvh, lds0 + snext * BLKB, wid, lane);
        lds_cptr P = (lds_cptr)shm + sprev * BLKB, C = (lds_cptr)shm + scur * BLKB;
        lds_cptr k0 = th ? P + KTB : P, k1 = th ? C : P + KTB, k2 = th ? C + KTB : C;
        const int vP = (int)lds0 + sprev * BLKB + 2 * KTB, vC = (int)lds0 + scur * BLKB + 2 * KTB;
        const int v0 = th ? vP + KTB : vP, v1 = th ? vC : vP + KTB, v2 = th ? vC + KTB : vC;
        const bool noprev = (nb == 0);
        const bool dead0 = noprev, dead1 = noprev && (th == 0);
        group32(qa, k0, k1, k2, v0, v1, v2, dead0, dead1, 0, sink2, qbase, gbase, shm + L_SCR + wid * 256, shm + L_OST + wid * 4096, lane);
        __builtin_amdgcn_sched_barrier(0);
        group32(qb, k0, k1, k2, v0, v1, v2, dead0, dead1, 32, sink2, qbase + (size_t)32 * LDP, gbase + (size_t)32 * LDP, shm + L_SCR + wid * 256, shm + L_OST + wid * 4096, lane);
    }
}
#undef SBAR
}
namespace ssd {
using att::bf16x8; using att::s16x4; using att::f32x16; using att::u32x4; using att::lds_ptr; using att::lds_cptr; using att::cvtpk; using att::glds16;
constexpr int CS = 2112;
constexpr int L_CK = 0, L_BK = 16 * CS, L_XK = 32 * CS, L_SK = L_XK + 8 * CS, L_TAB = L_SK + 16384, L_STG = L_TAB + 2048, L_END = L_STG + 32768;
typedef float f32x4 __attribute__((ext_vector_type(4)));
#define SBAR() __builtin_amdgcn_sched_barrier(0)
#define LASF __attribute__((address_space(3))) float
#define TRR(dst, addr, off) asm volatile("ds_read_b64_tr_b16 %0,%1 offset:%c2" : "=&v"(dst) : "v"(addr), "i"(off) : "memory")
__device__ __forceinline__ float bfl(unsigned w) { return __uint_as_float(w << 16); }
__device__ __forceinline__ float bfh(unsigned w) { return __uint_as_float(w & 0xffff0000u); }

__device__ __forceinline__ void ssd_chain(const unsigned short* xc, const float* dtp, unsigned short* proj, float* ssq, const float* a_log, const float* d_skip, int b, int h, lds_ptr shm, unsigned lds0) {
    const int tid = threadIdx.x, lane = tid & 63, r32 = lane & 31, hi = lane >> 5; const int wid = __builtin_amdgcn_readfirstlane(tid >> 6);
    const int lb = wid < 4 ? 3 - (wid >> 1) : (wid >> 1) - 2, pb = wid & 1, g = h >> 3;
    const float A2 = -expf(a_log[h]) * LOG2E, Dk = d_skip[h];
    f32x16 S = f32x16{};
    const int g16 = (lane >> 4) & 1, q4 = (lane & 15) >> 2, p4 = lane & 3;
    const int trl = (2 * g16 + (p4 >> 1)) * CS + (4 * hi + q4) * 16 + (p4 & 1) * 8;
    LASF* tab = (LASF*)(shm + L_TAB);
    for (int c = 0; c < 32; ++c) {
        const int bc = b * 32 + c; const size_t row0 = (size_t)b * SEQ + (size_t)c * 128;
        asm volatile("s_waitcnt vmcnt(0) lgkmcnt(0)\n\ts_barrier" ::: "memory");
        {
            const unsigned short* tb = xc + (size_t)bc * 192 * 1024 + (size_t)lane * 8;
#pragma unroll
            for (int i = 0; i < 10; ++i) { const int piece = wid + 8 * i; int cc, dst;
                if (i < 2) { cc = h * 8 + (piece >> 1); dst = L_XK + (piece >> 1) * CS + (piece & 1) * 1024; }
                else if (i < 6) { const int q = piece - 16; cc = 128 + g * 16 + (q >> 1); dst = L_BK + (q >> 1) * CS + (q & 1) * 1024; }
                else { const int q = piece - 48; cc = 160 + g * 16 + (q >> 1); dst = L_CK + (q >> 1) * CS + (q & 1) * 1024; }
                glds16(tb + (size_t)cc * 1024 + (piece & 1) * 512, (unsigned)__builtin_amdgcn_readfirstlane((int)(lds0 + dst))); }
        }
        unsigned short* zrow = proj + (row0 + 32 * lb + (lane >> 1)) * LDP + PC_Z + h * 64 + 32 * pb + 16 * (lane & 1);
        const u32x4 sz0 = *(const u32x4*)zrow, sz1 = *(const u32x4*)(zrow + 8);
        {   lds_ptr sk = shm + L_SK + (4 * lb) * 1024 + (32 * pb + r32) * 16 + hi * 8;
#pragma unroll
            for (int g4 = 0; g4 < 4; ++g4) {
                const unsigned lo = cvtpk(S[4 * g4], S[4 * g4 + 1]), hh = cvtpk(S[4 * g4 + 2], S[4 * g4 + 3]);
                *(__attribute__((address_space(3))) unsigned long long*)(sk + g4 * 1024) = (unsigned long long)lo | ((unsigned long long)hh << 32); }
        }
        if (wid == 0) {
            const float d0 = dtp[(row0 + 2 * lane) * 16 + h], d1 = dtp[(row0 + 2 * lane + 1) * 16 + h];
            const float a0 = d0 * A2, a1 = d1 * A2;
            float s = a0 + a1;
#pragma unroll
            for (int o = 1; o < 64; o <<= 1) { const float t = __shfl_up(s, o); if (lane >= o) s += t; }
            const float c1 = s, c0 = s - a1;
            const float T = __shfl(s, 63);
            tab[2 * lane] = c0; tab[2 * lane + 1] = c1; tab[128 + 2 * lane] = d0; tab[128 + 2 * lane + 1] = d1;
            tab[256 + 2 * lane] = __builtin_amdgcn_exp2f(T - c0) * d0; tab[256 + 2 * lane + 1] = __builtin_amdgcn_exp2f(T - c1) * d1;
            if (lane == 0) tab[384] = T;
        }
        asm volatile("s_waitcnt vmcnt(0) lgkmcnt(0)\n\ts_barrier" ::: "memory");
        SBAR();
        bf16x8 cf[8];
        { lds_cptr cp = (lds_cptr)shm + L_CK + hi * CS + (32 * lb + r32) * 16;
#pragma unroll
          for (int ks = 0; ks < 8; ++ks) cf[ks] = *(const __attribute__((address_space(3))) bf16x8*)(cp + ks * 2 * CS); }
        f32x16 y = f32x16{};
        { lds_cptr sp = (lds_cptr)shm + L_SK + hi * 1024 + (32 * pb + r32) * 16;
#pragma unroll
          for (int ks = 0; ks < 8; ++ks) { const bf16x8 sf = *(const __attribute__((address_space(3))) bf16x8*)(sp + ks * 2048); y = __builtin_amdgcn_mfma_f32_32x32x16_bf16(cf[ks], sf, y, 0, 0, 0); } }
        { const LASF* ap = tab + 32 * lb + 4 * hi;
#pragma unroll
          for (int g4 = 0; g4 < 4; ++g4) { const f32x4 av = *(const __attribute__((address_space(3))) f32x4*)(ap + 8 * g4);
              y[4 * g4] *= __builtin_amdgcn_exp2f(av.x); y[4 * g4 + 1] *= __builtin_amdgcn_exp2f(av.y); y[4 * g4 + 2] *= __builtin_amdgcn_exp2f(av.z); y[4 * g4 + 3] *= __builtin_amdgcn_exp2f(av.w); } }
        SBAR();
        const float acs_l = tab[32 * lb + r32];
        const int xb = (int)lds0 + L_XK + 4 * pb * CS + trl;
        for (int sb = 0; sb <= lb; ++sb) {
            f32x16 G = f32x16{};
            { lds_cptr bp = (lds_cptr)shm + L_BK + hi * CS + (32 * sb + r32) * 16;
#pragma unroll
              for (int ks = 0; ks < 8; ++ks) { const bf16x8 bfr = *(const __attribute__((address_space(3))) bf16x8*)(bp + ks * 2 * CS); G = __builtin_amdgcn_mfma_f32_32x32x16_bf16(bfr, cf[ks], G, 0, 0, 0); } }
            const bool diag = (sb == lb);
            { const LASF* ap = tab + 32 * sb + 4 * hi;
#pragma unroll
              for (int g4 = 0; g4 < 4; ++g4) { const f32x4 as = *(const __attribute__((address_space(3))) f32x4*)(ap + 8 * g4), ds = *(const __attribute__((address_space(3))) f32x4*)(ap + 128 + 8 * g4);
                  const int s0 = 8 * g4 + 4 * hi;
                  float m0 = G[4 * g4] * __builtin_amdgcn_exp2f(acs_l - as.x) * ds.x, m1 = G[4 * g4 + 1] * __builtin_amdgcn_exp2f(acs_l - as.y) * ds.y;
                  float m2 = G[4 * g4 + 2] * __builtin_amdgcn_exp2f(acs_l - as.z) * ds.z, m3 = G[4 * g4 + 3] * __builtin_amdgcn_exp2f(acs_l - as.w) * ds.w;
                  if (diag) { if (s0 > r32) m0 = 0.f; if (s0 + 1 > r32) m1 = 0.f; if (s0 + 2 > r32) m2 = 0.f; if (s0 + 3 > r32) m3 = 0.f; }
                  G[4 * g4] = m0; G[4 * g4 + 1] = m1; G[4 * g4 + 2] = m2; G[4 * g4 + 3] = m3; } }
            const u32x4 pw0 = (u32x4){cvtpk(G[0], G[1]), cvtpk(G[2], G[3]), cvtpk(G[4], G[5]), cvtpk(G[6], G[7])};
            const u32x4 pw1 = (u32x4){cvtpk(G[8], G[9]), cvtpk(G[10], G[11]), cvtpk(G[12], G[13]), cvtpk(G[14], G[15])};
            const int xbs = xb + sb * 512;
            s16x4 x0l, x0h, x1l, x1h;
            TRR(x0l, xbs, 0); TRR(x0h, xbs, 128); TRR(x1l, xbs, 256); TRR(x1h, xbs, 384);
            asm volatile("s_waitcnt lgkmcnt(0)" ::: "memory"); SBAR();
            const bf16x8 xf0 = (bf16x8){x0l[0], x0l[1], x0l[2], x0l[3], x0h[0], x0h[1], x0h[2], x0h[3]}, xf1 = (bf16x8){x1l[0], x1l[1], x1l[2], x1l[3], x1h[0], x1h[1], x1h[2], x1h[3]};
            y = __builtin_amdgcn_mfma_f32_32x32x16_bf16(__builtin_bit_cast(bf16x8, pw0), xf0, y, 0, 0, 0);
            y = __builtin_amdgcn_mfma_f32_32x32x16_bf16(__builtin_bit_cast(bf16x8, pw1), xf1, y, 0, 0, 0);
            if (diag) {
                const u32x4 u0 = __builtin_bit_cast(u32x4, xf0), u1 = __builtin_bit_cast(u32x4, xf1);
                y[0] += Dk * bfl(u0.x); y[1] += Dk * bfh(u0.x); y[2] += Dk * bfl(u0.y); y[3] += Dk * bfh(u0.y); y[4] += Dk * bfl(u0.z); y[5] += Dk * bfh(u0.z); y[6] += Dk * bfl(u0.w); y[7] += Dk * bfh(u0.w);
                y[8] += Dk * bfl(u1.x); y[9] += Dk * bfh(u1.x); y[10] += Dk * bfl(u1.y); y[11] += Dk * bfh(u1.y); y[12] += Dk * bfl(u1.z); y[13] += Dk * bfh(u1.z); y[14] += Dk * bfl(u1.w); y[15] += Dk * bfh(u1.w);
            }
            SBAR();
        }
        {
            const float eT = __builtin_amdgcn_exp2f(tab[384]);
#pragma unroll
            for (int r = 0; r < 16; ++r) S[r] *= eT;
            const int bb = (int)lds0 + L_BK + 4 * lb * CS + trl;
            const LASF* wp = tab + 256 + 4 * hi;
#pragma unroll
            for (int ks = 0; ks < 8; ++ks) {
                s16x4 bl, bh, xl, xh;
                TRR(bl, bb, ks * 256); TRR(bh, bb, ks * 256 + 128); TRR(xl, xb, ks * 256); TRR(xh, xb, ks * 256 + 128);
                const f32x4 wl = *(const __attribute__((address_space(3))) f32x4*)(wp + 16 * ks), wh = *(const __attribute__((address_space(3))) f32x4*)(wp + 16 * ks + 8);
                asm volatile("s_waitcnt lgkmcnt(0)" ::: "memory"); SBAR();
                const unsigned long long xlq = __builtin_bit_cast(unsigned long long, xl), xhq = __builtin_bit_cast(unsigned long long, xh);
                const unsigned xa = (unsigned)xlq, xbw = (unsigned)(xlq >> 32), xc2 = (unsigned)xhq, xd = (unsigned)(xhq >> 32);
                const u32x4 xs = (u32x4){cvtpk(bfl(xa) * wl.x, bfh(xa) * wl.y), cvtpk(bfl(xbw) * wl.z, bfh(xbw) * wl.w), cvtpk(bfl(xc2) * wh.x, bfh(xc2) * wh.y), cvtpk(bfl(xd) * wh.z, bfh(xd) * wh.w)};
                const bf16x8 btf = (bf16x8){bl[0], bl[1], bl[2], bl[3], bh[0], bh[1], bh[2], bh[3]};
                S = __builtin_amdgcn_mfma_f32_32x32x16_bf16(btf, __builtin_bit_cast(bf16x8, xs), S, 0, 0, 0);
            }
        }
        SBAR();
        {
            LASF* stg = (LASF*)(shm + L_STG + wid * 4096);
            LASF* stl = stg + 4 * hi * 32 + r32; asm volatile("" : "+v"(stl));
#pragma unroll
            for (int r = 0; r < 16; ++r) stl[((r & 3) + 8 * (r >> 2)) * 32] = y[r];
            asm volatile("s_waitcnt lgkmcnt(0)" ::: "memory");
            const LASF* rd = stg + (lane >> 1) * 32 + (lane & 1) * 16;
            const f32x4 v0 = *(const __attribute__((address_space(3))) f32x4*)(rd), v1 = *(const __attribute__((address_space(3))) f32x4*)(rd + 4), v2 = *(const __attribute__((address_space(3))) f32x4*)(rd + 8), v3 = *(const __attribute__((address_space(3))) f32x4*)(rd + 12);
            float o[16];
            o[0] = v0.x * bfl(sz0.x); o[1] = v0.y * bfh(sz0.x); o[2] = v0.z * bfl(sz0.y); o[3] = v0.w * bfh(sz0.y);
            o[4] = v1.x * bfl(sz0.z); o[5] = v1.y * bfh(sz0.z); o[6] = v1.z * bfl(sz0.w); o[7] = v1.w * bfh(sz0.w);
            o[8] = v2.x * bfl(sz1.x); o[9] = v2.y * bfh(sz1.x); o[10] = v2.z * bfl(sz1.y); o[11] = v2.w * bfh(sz1.y);
            o[12] = v3.x * bfl(sz1.z); o[13] = v3.y * bfh(sz1.z); o[14] = v3.z * bfl(sz1.w); o[15] = v3.w * bfh(sz1.w);
            float q = 0.f;
#pragma unroll
            for (int e = 0; e < 16; ++e) q += o[e] * o[e];
            q += __shfl_xor(q, 1);
            if ((lane & 1) == 0) ssq[(row0 + 32 * lb + (lane >> 1)) * 32 + h * 2 + pb] = q;
            *(u32x4*)zrow = (u32x4){cvtpk(o[0], o[1]), cvtpk(o[2], o[3]), cvtpk(o[4], o[5]), cvtpk(o[6], o[7])};
            *(u32x4*)(zrow + 8) = (u32x4){cvtpk(o[8], o[9]), cvtpk(o[10], o[11]), cvtpk(o[12], o[13]), cvtpk(o[14], o[15])};
            asm volatile("s_waitcnt lgkmcnt(0)" ::: "memory");
        }
    }
}
#undef SBAR
#undef LASF
#undef TRR
}
#define XB_TMO      128
#define XB_XCNT(j)  (256  + 64 * (j))
#define XB_XSUB(j)  (1280 + 64 * (j))
#define XB_XGEN(j)  (2304 + 64 * (j))
#define XB_TOP      3328
#define XB_TOPGEN   3392
#define XCD_BAR_WORDS 3456
#define XB_SPIN_CAP (1u << 18)
__device__ __forceinline__ unsigned xb_ld(unsigned* p)              { return __hip_atomic_load(p, __ATOMIC_RELAXED, __HIP_MEMORY_SCOPE_AGENT); }
__device__ __forceinline__ unsigned xb_add(unsigned* p, unsigned v) { return __hip_atomic_fetch_add(p, v, __ATOMIC_RELAXED, __HIP_MEMORY_SCOPE_AGENT); }
__device__ __forceinline__ unsigned xb_xcc_id() { return (unsigned)__builtin_amdgcn_s_getreg((3 << 11) | 20) & 0xFu; }
#define XB_SPIN(cond, bar) do { unsigned _sp = 0; while (cond) { __builtin_amdgcn_s_sleep(1); \
    if ((++_sp & 255u) == 0u) { if (xb_ld(&(bar)[XB_TMO])) break; if (_sp > XB_SPIN_CAP) { atomicAdd(&(bar)[XB_TMO], 1u); break; } } } } while (0)
struct XcdBarrier { unsigned* bar; unsigned x; volatile LAS unsigned* st; };
__device__ __forceinline__ XcdBarrier xcd_barrier_post(unsigned* bar, volatile LAS unsigned* st) {
    XcdBarrier b; b.bar = bar; b.x = xb_xcc_id(); b.st = st;
    if (threadIdx.x == 0) (void)xb_add(&bar[XB_XCNT(b.x)], 1u);
    return b;
}
__device__ __forceinline__ void xcd_barrier_complete(unsigned* bar, unsigned x, unsigned& nloc, unsigned& nx) {
    const unsigned G = gridDim.x * gridDim.y * gridDim.z;
    unsigned sum, cnt, mine, sp = 0u;
    for (;;) {
        sum = 0u; cnt = 0u; mine = 0u;
#pragma unroll
        for (unsigned j = 0; j < 16; ++j) { const unsigned c = xb_ld(&bar[XB_XCNT(j)]); sum += c; cnt += (c > 0u) ? 1u : 0u; mine = (j == x) ? c : mine; }
        if (sum == G) break;
        __builtin_amdgcn_s_sleep(1);
        if ((++sp & 255u) == 0u) { if (xb_ld(&bar[XB_TMO])) break; if (sp > XB_SPIN_CAP) { atomicAdd(&bar[XB_TMO], 1u); break; } }
    }
    nloc = mine > 0u ? mine : 1u; nx = cnt > 0u ? cnt : 1u;
}
__device__ __forceinline__ void xcd_barrier(const XcdBarrier& b) {
    asm volatile("s_waitcnt vmcnt(0)" ::: "memory");
    __syncthreads();
    if (threadIdx.x == 0) {
        unsigned* bar = b.bar;
        __builtin_amdgcn_s_waitcnt(0);
        unsigned nloc = b.st[0], nx = b.st[1];
        if (nloc == 0u) { xcd_barrier_complete(bar, b.x, nloc, nx); b.st[0] = nloc; b.st[1] = nx; }
        const unsigned old = xb_add(&bar[XB_XSUB(b.x)], 1u);
        const unsigned gen = old / nloc;
        if (old + 1u == (gen + 1u) * nloc) {
            __builtin_amdgcn_fence(__ATOMIC_RELEASE, "agent");
            asm volatile("s_waitcnt vmcnt(0)" ::: "memory");
            const unsigned og = xb_add(&bar[XB_TOP], 1u);
            const unsigned tg = og / nx;
            if (og + 1u == (tg + 1u) * nx) xb_add(&bar[XB_TOPGEN], 1u);
            else XB_SPIN(xb_ld(&bar[XB_TOPGEN]) == tg, bar);
            __builtin_amdgcn_fence(__ATOMIC_ACQUIRE, "agent");
            xb_add(&bar[XB_XGEN(b.x)], 1u);
            asm volatile("s_waitcnt vmcnt(0)" ::: "memory");
        } else {
            XB_SPIN(xb_ld(&bar[XB_XGEN(b.x)]) == gen, bar);
            __builtin_amdgcn_fence(__ATOMIC_ACQUIRE, "agent");
            asm volatile("s_waitcnt vmcnt(0)" ::: "memory");
        }
    }
    __syncthreads();
}

struct Args {
    const float* x; const int* pos; const float* w_in; const float* conv_w; const float* conv_b; const float* dt_bias; const float* a_log;
    const float* d_skip; const float* norm_w; const float* sinks; const float* w_out; const float* ln_g; const float* ln_b;
    float* out; unsigned char* ws; int ph_lo, ph_hi;
};
struct Frame {
    LAS unsigned char* lds; int tid, lane, wave, vcu, G;
    bf16 *w_in_t, *w_out_t, *xb, *proj, *xc; float *cosT, *sinT, *dt, *ssq;
};

__device__ __forceinline__ int win_src_col(int n) {
    if (n < 1024) return n; if (n < 2048) return OFF_Q + n - 1024; if (n < 3584) return OFF_XBC + n - 2048;
    if (n < 3840) return OFF_K + n - 3584; if (n < 4096) return OFF_V + n - 3840; return OFF_G + n - 4096;
}
__device__ __forceinline__ void transpose_item(const float* W, int ldw, int srccol0, float scale, bf16* WT, int ldk, int n0, int k0, LAS float* scr, int lane) {
#pragma unroll 8
    for (int i = 0; i < 32; ++i) { const int kk = 2 * i + (lane >> 5); scr[kk * 33 + (lane & 31)] = W[(size_t)(k0 + kk) * ldw + srccol0 + (lane & 31)] * scale; }
    LDS_WAIT(); asm volatile("" ::: "memory");
    const int c = lane & 7;
#pragma unroll
    for (int j = 0; j < 4; ++j) { const int n = (lane >> 3) + 8 * j; const LAS float* s = scr + (8 * c) * 33 + n;
        v4u o; o.x = pk2(s[0 * 33], s[1 * 33]); o.y = pk2(s[2 * 33], s[3 * 33]); o.z = pk2(s[4 * 33], s[5 * 33]); o.w = pk2(s[6 * 33], s[7 * 33]);
        *(GAS v4u*)(WT + (size_t)(n0 + n) * ldk + k0 + 8 * c) = o; }
    LDS_WAIT(); asm volatile("" ::: "memory");
}
__device__ __forceinline__ void p0_prologue(const Args& a, Frame& F) {
    LAS float* scr = (LAS float*)(F.lds + F.wave * 8448);
    const int gw = F.vcu * NWAVES + F.wave, NGW = F.G * NWAVES;
    constexpr int I_IN = (1024 / 64) * (5120 / 32), I_OUT = (2048 / 64) * (1024 / 32);
    for (int it = gw; it < I_IN + I_OUT; it += NGW) {
        if (it < I_IN) { const int nblk = 5120 / 32, kb = it / nblk, nb = it % nblk, n0 = 32 * nb;
            transpose_item(a.w_in, DIN, win_src_col(n0), (n0 >= 1024 && n0 < 2048) ? C2 : 1.0f, F.w_in_t, 1024, n0, 64 * kb, scr, F.lane); }
        else { const int r = it - I_IN, nblk = 1024 / 32, kb = r / nblk, nb = r % nblk;
            transpose_item(a.w_out, 1024, 32 * nb, 1.0f, F.w_out_t, 2048, 32 * nb, 64 * kb, scr, F.lane); }
    }
    __syncthreads();
    LAS float* wdt = (LAS float*)(F.lds);
    for (int i = F.tid; i < 16 * 1024; i += NTHREADS) { const int k = i >> 4, h = i & 15; wdt[h * 1024 + k] = a.w_in[(size_t)k * DIN + OFF_DT + h]; }
    __syncthreads();
    const int lane = F.lane;
    float myb = a.dt_bias[lane >> 2];
    for (int m = gw; m < MTOK; m += NGW) {
        const GAS f32x4* xr = (const GAS f32x4*)(a.x + (size_t)m * DMODEL) + lane;
        f32x4 v[4];
#pragma unroll
        for (int j = 0; j < 4; ++j) v[j] = xr[64 * j];
        GAS unsigned long long* o8 = (GAS unsigned long long*)(F.xb + (size_t)m * DMODEL) + lane;
#pragma unroll
        for (int j = 0; j < 4; ++j) o8[64 * j] = (unsigned long long)pk2(v[j].x, v[j].y) | ((unsigned long long)pk2(v[j].z, v[j].w) << 32);
        float acc[16];
#pragma unroll
        for (int h = 0; h < 16; ++h) { float s = 0.f;
#pragma unroll
            for (int j = 0; j < 4; ++j) { const f32x4 w = *(const LAS f32x4*)(wdt + h * 1024 + 256 * j + 4 * lane); s += (v[j].x * w.x + v[j].y * w.y) + (v[j].z * w.z + v[j].w * w.w); }
            acc[h] = s; if (h & 1) asm volatile("" ::: "memory"); }
        float r8[8], r4[4], r2[2], r1;
        const bool b5 = lane & 32, b4 = lane & 16, b3 = lane & 8, b2 = lane & 4;
#pragma unroll
        for (int i = 0; i < 8; ++i) { const float snd = b5 ? acc[i] : acc[i + 8], kp = b5 ? acc[i + 8] : acc[i]; r8[i] = kp + __shfl_xor(snd, 32); }
#pragma unroll
        for (int i = 0; i < 4; ++i) { const float snd = b4 ? r8[i] : r8[i + 4], kp = b4 ? r8[i + 4] : r8[i]; r4[i] = kp + __shfl_xor(snd, 16); }
#pragma unroll
        for (int i = 0; i < 2; ++i) { const float snd = b3 ? r4[i] : r4[i + 2], kp = b3 ? r4[i + 2] : r4[i]; r2[i] = kp + __shfl_xor(snd, 8); }
        { const float snd = b2 ? r2[0] : r2[1], kp = b2 ? r2[1] : r2[0]; r1 = kp + __shfl_xor(snd, 4); }
        r1 += __shfl_xor(r1, 1); r1 += __shfl_xor(r1, 2);
        const float pre = r1 + myb;
        const float dtv = pre > 20.f ? pre : log1pf(expf(pre));
        if ((lane & 3) == 0) F.dt[(size_t)m * 16 + (lane >> 2)] = dtv;
    }
    const int gt = F.vcu * NTHREADS + F.tid, GT = F.G * NTHREADS;
    for (int idx = gt; idx < MTOK * 8; idx += GT) {
        const int m = idx >> 3, i = idx & 7;
        const float inv = exp2f(-(float)i * 2.366446071165522f);
        const float ang = (float)a.pos[m] * inv;
        double rev = (double)ang * 0.15915494309189535; rev -= __builtin_rint(rev);
        F.cosT[idx] = __builtin_amdgcn_cosf((float)rev); F.sinT[idx] = __builtin_amdgcn_sinf((float)rev);
    }
}

__device__ __forceinline__ void p_rope(Frame& F) {
    const int gt = F.vcu * NTHREADS + F.tid, GT = F.G * NTHREADS;
    for (int item = gt; item < MTOK * 160; item += GT) {
        const int i = item & 7, hd = (item >> 3) % 20, m = item / 160;
        const int col = hd < 16 ? PC_Q + hd * 64 : PC_K + (hd - 16) * 64;
        bf16* p = F.proj + (size_t)m * LDP + col;
        const float r1 = bf2f(p[i]), r2 = bf2f(p[i + 8]), c = F.cosT[m * 8 + i], s = F.sinT[m * 8 + i];
        p[i] = (bf16)f2bf(r1 * c - r2 * s); p[i + 8] = (bf16)f2bf(r2 * c + r1 * s);
    }
}
__device__ __forceinline__ void p_conv(const Args& a, Frame& F) {
    const int gt = F.vcu * NTHREADS + F.tid, GT = F.G * NTHREADS;
    for (int item = gt; item < (MTOK / 16) * 192; item += GT) {
        const int cg = item % 192, rb = item / 192, r0 = rb * 16, ch = cg * 8;
        float w[4][8], bias[8], win[3][8];
#pragma unroll
        for (int k = 0; k < 4; ++k) { const f32x4 w0 = *(const f32x4*)(a.conv_w + k * DXBC + ch), w1 = *(const f32x4*)(a.conv_w + k * DXBC + ch + 4);
            w[k][0] = w0.x; w[k][1] = w0.y; w[k][2] = w0.z; w[k][3] = w0.w; w[k][4] = w1.x; w[k][5] = w1.y; w[k][6] = w1.z; w[k][7] = w1.w; }
        { const f32x4 b0 = *(const f32x4*)(a.conv_b + ch), b1 = *(const f32x4*)(a.conv_b + ch + 4);
            bias[0] = b0.x; bias[1] = b0.y; bias[2] = b0.z; bias[3] = b0.w; bias[4] = b1.x; bias[5] = b1.y; bias[6] = b1.z; bias[7] = b1.w; }
        const bool seq_start = (r0 & (SEQ - 1)) == 0;
#pragma unroll
        for (int k = 0; k < 3; ++k) {
            v4u q = (v4u){0u, 0u, 0u, 0u};
            if (!seq_start) q = *(const GAS v4u*)(F.proj + (size_t)(r0 - 3 + k) * LDP + PC_XBC + ch);
            win[k][0] = bflo(q.x); win[k][1] = bfhi(q.x); win[k][2] = bflo(q.y); win[k][3] = bfhi(q.y); win[k][4] = bflo(q.z); win[k][5] = bfhi(q.z); win[k][6] = bflo(q.w); win[k][7] = bfhi(q.w);
        }
        bf16* outp = F.xc + ((size_t)((r0 >> 7) * 192 + cg) * 128 + (r0 & 127)) * 8;
#pragma unroll
        for (int r = 0; r < 16; ++r) {
            const v4u q = *(const GAS v4u*)(F.proj + (size_t)(r0 + r) * LDP + PC_XBC + ch);
            float cur[8] = {bflo(q.x), bfhi(q.x), bflo(q.y), bfhi(q.y), bflo(q.z), bfhi(q.z), bflo(q.w), bfhi(q.w)};
            float o[8];
#pragma unroll
            for (int e = 0; e < 8; ++e) { const float s = bias[e] + w[0][e] * win[0][e] + w[1][e] * win[1][e] + w[2][e] * win[2][e] + w[3][e] * cur[e]; o[e] = silu_f(s); }
            v4u ov; ov.x = pk2(o[0], o[1]); ov.y = pk2(o[2], o[3]); ov.z = pk2(o[4], o[5]); ov.w = pk2(o[6], o[7]);
            *(GAS v4u*)(outp + r * 8) = ov;
#pragma unroll
            for (int e = 0; e < 8; ++e) { win[0][e] = win[1][e]; win[1][e] = win[2][e]; win[2][e] = cur[e]; }
        }
    }
}
__device__ __forceinline__ void p_ssd(const Args& a, Frame& F) {
    static_assert(ssd::L_END <= RING_BYTES, "SSD LDS map");
    for (int bh = F.vcu; bh < BATCH * NH; bh += F.G)
        ssd::ssd_chain(F.xc, F.dt, F.proj, F.ssq, a.a_log, a.d_skip, bh / NH, bh % NH, (att::lds_ptr)F.lds, (unsigned)(size_t)F.lds);
}
__device__ __forceinline__ void p_norm_apply(const Args& a, Frame& F) {
    const int gw = F.vcu * NWAVES + F.wave, NGW = F.G * NWAVES, lane = F.lane;
    for (int m = gw; m < MTOK; m += NGW) {
        GAS v2u* zr = (GAS v2u*)(F.proj + (size_t)m * LDP + PC_Z) + lane;
        float s = lane < 32 ? F.ssq[(size_t)m * 32 + lane] : 0.f;
        float s0 = lane < 16 ? s : 0.f, s1 = (lane >= 16 && lane < 32) ? s : 0.f;
        s0 = wave_sum(s0); s1 = wave_sum(s1);
        const float r0 = 1.f / sqrtf(s0 * (1.f / 512.f) + RMS_EPS), r1 = 1.f / sqrtf(s1 * (1.f / 512.f) + RMS_EPS);
#pragma unroll
        for (int j = 0; j < 4; ++j) { const f32x4 nw = *(const f32x4*)(a.norm_w + 256 * j + 4 * lane); const float rr = j < 2 ? r0 : r1; const v2u zq = zr[64 * j];
            v2u o; o.x = pk2(bflo(zq.x) * rr * nw.x, bfhi(zq.x) * rr * nw.y); o.y = pk2(bflo(zq.y) * rr * nw.z, bfhi(zq.y) * rr * nw.w); zr[64 * j] = o; }
    }
}
__device__ __forceinline__ void p_ssd_naive(const Args& a, Frame& F, float* yout) {
    LAS float* Bs = (LAS float*)F.lds; LAS float* Cs = Bs + 64 * 128; LAS float* xs = Cs + 64 * 128; LAS float* dts = xs + 64 * 64;
    const int tid = F.tid, p = tid >> 3, nq = tid & 7;
    for (int bh = F.vcu; bh < BATCH * NH; bh += F.G) {
        const int b = bh / NH, h = bh % NH, g = h >> 3;
        const float A = -expf(a.a_log[h]), Dk = a.d_skip[h];
        float st[16];
#pragma unroll
        for (int i = 0; i < 16; ++i) st[i] = 0.f;
        for (int c0 = 0; c0 < SEQ; c0 += 64) {
            __syncthreads();
            const size_t row0 = (size_t)b * SEQ + c0;
            for (int i = tid; i < 64 * 16; i += NTHREADS) { const int r = i >> 4, c8 = (i & 15) * 8;
                const v4u qb = *(const GAS v4u*)(F.xc + (row0 + r) * DXBC + 1024 + g * 128 + c8), qc = *(const GAS v4u*)(F.xc + (row0 + r) * DXBC + 1280 + g * 128 + c8);
                LAS float* bd = Bs + r * 128 + c8; LAS float* cd = Cs + r * 128 + c8;
                bd[0] = bflo(qb.x); bd[1] = bfhi(qb.x); bd[2] = bflo(qb.y); bd[3] = bfhi(qb.y); bd[4] = bflo(qb.z); bd[5] = bfhi(qb.z); bd[6] = bflo(qb.w); bd[7] = bfhi(qb.w);
                cd[0] = bflo(qc.x); cd[1] = bfhi(qc.x); cd[2] = bflo(qc.y); cd[3] = bfhi(qc.y); cd[4] = bflo(qc.z); cd[5] = bfhi(qc.z); cd[6] = bflo(qc.w); cd[7] = bfhi(qc.w); }
            { const int r = tid >> 3, c8 = (tid & 7) * 8; const v4u qx = *(const GAS v4u*)(F.xc + (row0 + r) * DXBC + h * 64 + c8); LAS float* xd = xs + r * 64 + c8;
                xd[0] = bflo(qx.x); xd[1] = bfhi(qx.x); xd[2] = bflo(qx.y); xd[3] = bfhi(qx.y); xd[4] = bflo(qx.z); xd[5] = bfhi(qx.z); xd[6] = bflo(qx.w); xd[7] = bfhi(qx.w); }
            if (tid < 64) dts[tid] = F.dt[(row0 + tid) * 16 + h];
            __syncthreads();
            for (int r = 0; r < 64; ++r) {
                const float dtv = dts[r], dA = expf(dtv * A), xp = xs[r * 64 + p], xdt = xp * dtv;
                float part = 0.f;
#pragma unroll
                for (int q4 = 0; q4 < 4; ++q4) { const f32x4 bv = *(const LAS f32x4*)(Bs + r * 128 + nq * 16 + 4 * q4), cv = *(const LAS f32x4*)(Cs + r * 128 + nq * 16 + 4 * q4);
                    st[4 * q4 + 0] = st[4 * q4 + 0] * dA + xdt * bv.x; part += st[4 * q4 + 0] * cv.x;
                    st[4 * q4 + 1] = st[4 * q4 + 1] * dA + xdt * bv.y; part += st[4 * q4 + 1] * cv.y;
                    st[4 * q4 + 2] = st[4 * q4 + 2] * dA + xdt * bv.z; part += st[4 * q4 + 2] * cv.z;
                    st[4 * q4 + 3] = st[4 * q4 + 3] * dA + xdt * bv.w; part += st[4 * q4 + 3] * cv.w; }
                part += __shfl_xor(part, 1); part += __shfl_xor(part, 2); part += __shfl_xor(part, 4);
                if (nq == 0) yout[(row0 + r) * 1024 + h * 64 + p] = part + Dk * xp;
            }
        }
    }
}
__device__ __forceinline__ void p_gate_norm(const Args& a, Frame& F, const float* yin) {
    const int gw = F.vcu * NWAVES + F.wave, NGW = F.G * NWAVES, lane = F.lane;
    for (int m = gw; m < MTOK; m += NGW) {
        const GAS f32x4* yr = (const GAS f32x4*)(yin + (size_t)m * 1024) + lane;
        GAS v2u* zr = (GAS v2u*)(F.proj + (size_t)m * LDP + PC_Z) + lane;
        float yg[16]; float ss0 = 0.f, ss1 = 0.f;
#pragma unroll
        for (int j = 0; j < 4; ++j) { const f32x4 yv = yr[64 * j]; const v2u zq = zr[64 * j];
            const float z0 = bflo(zq.x), z1 = bfhi(zq.x), z2 = bflo(zq.y), z3 = bfhi(zq.y);
            yg[4 * j + 0] = yv.x * z0; yg[4 * j + 1] = yv.y * z1; yg[4 * j + 2] = yv.z * z2; yg[4 * j + 3] = yv.w * z3;
            const float q = (yg[4 * j] * yg[4 * j] + yg[4 * j + 1] * yg[4 * j + 1]) + (yg[4 * j + 2] * yg[4 * j + 2] + yg[4 * j + 3] * yg[4 * j + 3]);
            if (j < 2) ss0 += q; else ss1 += q; }
        ss0 = wave_sum(ss0); ss1 = wave_sum(ss1);
        const float r0 = 1.f / sqrtf(ss0 * (1.f / 512.f) + RMS_EPS), r1 = 1.f / sqrtf(ss1 * (1.f / 512.f) + RMS_EPS);
#pragma unroll
        for (int j = 0; j < 4; ++j) { const f32x4 nw = *(const f32x4*)(a.norm_w + 256 * j + 4 * lane); const float rr = j < 2 ? r0 : r1;
            v2u o; o.x = pk2(yg[4 * j] * rr * nw.x, yg[4 * j + 1] * rr * nw.y); o.y = pk2(yg[4 * j + 2] * rr * nw.z, yg[4 * j + 3] * rr * nw.w); zr[64 * j] = o; }
    }
}
__device__ __forceinline__ void p_attn_naive(const Args& a, Frame& F) {
    const int gw = F.vcu * NWAVES + F.wave, NGW = F.G * NWAVES, lane = F.lane;
    for (int item = gw; item < MTOK * 16; item += NGW) {
        const int hq = item & 15, t = item >> 4, tl = t & (SEQ - 1), kvh = hq >> 2;
        bf16* qp = F.proj + (size_t)t * LDP + PC_Q + hq * 64 + lane;
        const float q = bf2f(*qp);
        float m2 = a.sinks[hq] * LOG2E, l = 1.f, acc = 0.f;
        const int nk = tl < 127 ? tl + 1 : 128;
        const bf16* kp = F.proj + (size_t)(t - nk + 1) * LDP + PC_K + kvh * 64 + lane;
        for (int j = 0; j < nk; ++j) {
            const float kv = bf2f(kp[(size_t)j * LDP]), vv = bf2f(kp[(size_t)j * LDP + (PC_V - PC_K)]);
            const float s = wave_sum(q * kv);
            const float mn = fmaxf(m2, s), f = exp2f(m2 - mn), pp = exp2f(s - mn);
            l = l * f + pp; acc = acc * f + pp * vv; m2 = mn;
        }
        const float gv = bf2f(F.proj[(size_t)t * LDP + PC_G + hq * 64 + lane]);
        *qp = (bf16)f2bf(acc / l * gv);
    }
}
__device__ __forceinline__ void p_attn(const Args& a, Frame& F) {
    static_assert(att::L_END <= RING_BYTES, "attention LDS map");
    for (int run = F.vcu; run < 256; run += F.G) { const int b = run >> 5, kvh = (run >> 3) & 3, nb0 = (run & 7) * 4;
        att::attn_run(F.proj, a.sinks, b, kvh, nb0, 4, (att::lds_ptr)F.lds, (unsigned)(size_t)F.lds); }
}
__device__ __forceinline__ void p_ln(const Args& a, Frame& F) {
    const int gw = F.vcu * NWAVES + F.wave, NGW = F.G * NWAVES, lane = F.lane;
    for (int m = gw; m < MTOK; m += NGW) {
        const GAS f32x4* xr = (const GAS f32x4*)(a.x + (size_t)m * DMODEL) + lane;
        GAS f32x4* hr = (GAS f32x4*)(a.out + (size_t)m * DMODEL) + lane;
        f32x4 v[4]; float s = 0.f;
#pragma unroll
        for (int j = 0; j < 4; ++j) { v[j] = xr[64 * j] * ALPHA + hr[64 * j]; s += (v[j].x + v[j].y) + (v[j].z + v[j].w); }
        const float mean = wave_sum(s) * (1.f / DMODEL); float s2 = 0.f;
#pragma unroll
        for (int j = 0; j < 4; ++j) { v[j] = v[j] - mean; s2 += (v[j].x * v[j].x + v[j].y * v[j].y) + (v[j].z * v[j].z + v[j].w * v[j].w); }
        const float rstd = 1.f / sqrtf(wave_sum(s2) * (1.f / DMODEL) + LN_EPS);
#pragma unroll
        for (int j = 0; j < 4; ++j) { const f32x4 gg = *(const f32x4*)(a.ln_g + 256 * j + 4 * lane), bb = *(const f32x4*)(a.ln_b + 256 * j + 4 * lane);
            hr[64 * j] = v[j] * rstd * gg + bb; }
    }
}

constexpr int N_PHASES = 9;
#ifndef MK_ONE_LAUNCH
#define MK_ONE_LAUNCH 1
#endif
__global__ void __launch_bounds__(NTHREADS, 2) mk_fwd(Args args) {
    extern __shared__ __attribute__((aligned(16))) unsigned char lds[];
    Frame F;
    F.lds = (LAS unsigned char*)lds;
    F.tid = threadIdx.x; F.lane = F.tid & 63; F.wave = __builtin_amdgcn_readfirstlane(F.tid >> 6);
    F.G = gridDim.x; { const int bx = blockIdx.x; F.vcu = (F.G % 8 == 0) ? (bx % 8) * (F.G / 8) + bx / 8 : bx; }
    unsigned char* ws = args.ws;
    F.w_in_t = (bf16*)(ws + WS_WIN); F.w_out_t = (bf16*)(ws + WS_WOUT); F.xb = (bf16*)(ws + WS_XB); F.proj = (bf16*)(ws + WS_PROJ); F.xc = (bf16*)(ws + WS_XC);
    F.cosT = (float*)(ws + WS_COS); F.sinT = (float*)(ws + WS_SIN); F.dt = (float*)(ws + WS_DT); F.ssq = (float*)(ws + WS_SSQ);
    volatile LAS unsigned* MISC = (volatile LAS unsigned*)(F.lds + MISC_OFF);
    for (int u = F.tid; u < (LDS_BYTES - LDSCTL_OFF) / 4; u += NTHREADS) ((LAS unsigned*)(F.lds + LDSCTL_OFF))[u] = 0u;
    __syncthreads();
    XcdBarrier bar; bar.bar = (unsigned*)(ws + WS_CTL) + CW_BAR; bar.x = 0; bar.st = nullptr;
    if (MK_ONE_LAUNCH) bar = xcd_barrier_post((unsigned*)(ws + WS_CTL) + CW_BAR, MISC + 8);
    const int lo = args.ph_lo, hi = args.ph_hi;
#define IN(k) (lo <= (k) && (k) < hi)
#define SEAM(k) do { if (IN(k) && IN((k) + 1)) xcd_barrier(bar); } while (0)
    if (IN(0)) { p0_prologue(args, F); SEAM(0); }
    if (IN(1)) {
        pg8::Gemm g{F.xb, F.w_in_t, MTOK, LDP, DMODEL, DMODEL, DMODEL}; pg8::StaticOrder S; S.init(MTOK, LDP, F.G, (int)blockIdx.x);
        pg8::EpiProj E{F.proj, LDP, F.cosT, F.sinT};
        pg8::gemm_phase<pg8::EpiProj, pg8::StaticOrder, true, true>(F.lds, g, S, E);
        SEAM(1);
    }
    if (IN(2)) { SEAM(2); }
    if (IN(3)) { p_conv(args, F); SEAM(3); }
    if (IN(4)) { p_ssd(args, F); SEAM(4); }
    if (IN(5)) { p_norm_apply(args, F); SEAM(5); }
    if (IN(6)) { p_attn(args, F); SEAM(6); }
    if (IN(7)) {
        pg8::Gemm g{F.proj, F.w_out_t, MTOK, DMODEL, 2048, LDP, 2048}; pg8::StaticOrder S; S.init(MTOK, DMODEL, F.G, (int)blockIdx.x);
        pg8::EpiF32 E{args.out, DMODEL};
        pg8::gemm_phase<pg8::EpiF32, pg8::StaticOrder, true, true>(F.lds, g, S, E);
        SEAM(7);
    }
    if (IN(8)) { p_ln(args, F); }
#undef IN
#undef SEAM
}

extern "C" void kernel_launch(void* const* d_in, const int* in_sizes, int n_in, void* d_out, int out_size, void* d_ws, size_t ws_size, hipStream_t stream) {
    static int grid = 0;
    if (grid == 0) {
        if (n_in != 13 || in_sizes[0] != MTOK * DMODEL || out_size != MTOK * DMODEL || ws_size < WS_END) {
            fprintf(stderr, "kernel_launch: unexpected shapes (n_in %d, in0 %d, out %d, ws %zu); nothing launched\n", n_in, n_in > 0 ? in_sizes[0] : -1, out_size, ws_size); grid = -1; return; }
        int dev = 0, cus = 0;
        if (hipGetDevice(&dev) != hipSuccess || hipDeviceGetAttribute(&cus, hipDeviceAttributeMultiprocessorCount, dev) != hipSuccess) { grid = -1; return; }
        if (hipFuncSetAttribute((const void*)mk_fwd, hipFuncAttributeMaxDynamicSharedMemorySize, LDS_BYTES) != hipSuccess) { fprintf(stderr, "kernel_launch: hipFuncSetAttribute failed\n"); grid = -1; return; }
        int per_cu = 0;
        if (hipOccupancyMaxActiveBlocksPerMultiprocessor(&per_cu, (const void*)mk_fwd, NTHREADS, LDS_BYTES) != hipSuccess || per_cu < 1) fprintf(stderr, "kernel_launch: occupancy query reports %d\n", per_cu);
        (void)hipGetLastError();
        grid = cus;
    }
    if (grid < 0) return;
    if (hipMemsetAsync((char*)d_ws + WS_CTL, 0, CTL_ZERO_BYTES, stream) != hipSuccess) return;
    Args a{};
    a.x = (const float*)d_in[0]; a.pos = (const int*)d_in[1]; a.w_in = (const float*)d_in[2]; a.conv_w = (const float*)d_in[3]; a.conv_b = (const float*)d_in[4];
    a.dt_bias = (const float*)d_in[5]; a.a_log = (const float*)d_in[6]; a.d_skip = (const float*)d_in[7]; a.norm_w = (const float*)d_in[8]; a.sinks = (const float*)d_in[9];
    a.w_out = (const float*)d_in[10]; a.ln_g = (const float*)d_in[11]; a.ln_b = (const float*)d_in[12];
    a.out = (float*)d_out; a.ws = (unsigned char*)d_ws;
#if MK_ONE_LAUNCH
    a.ph_lo = 0; a.ph_hi = N_PHASES;
    hipLaunchKernelGGL(mk_fwd, dim3(grid), dim3(NTHREADS), LDS_BYTES, stream, a);
#else
    for (int p = 0; p < N_PHASES; ++p) { a.ph_lo = p; a.ph_hi = p + 1; hipLaunchKernelGGL(mk_fwd, dim3(grid), dim3(NTHREADS), LDS_BYTES, stream, a); }
#endif
}
```
